# Optimizing an MI355X kernel written in HIP

```python
import math
import jax, jax.numpy as jnp
from jax import lax
import numpy as np

D_MODEL = 2048
BATCH = 2
SEQ = 4096
DEPTH = 4

GRID_W = 64
CTX_LEN = 256
HEAD_DIM = 128
Q_BLOCK = 128
ROPE_BASE = 10000.0
EPS = 1e-6
NEG_INF = -1e30

A_HEADS = 8
A_QK_DIM = 64
A_V_DIM = 128
B_HEADS = 8
B_KV_HEADS = 2
WINDOW = 128
NBAND = (WINDOW + Q_BLOCK - 1) // Q_BLOCK
PAD = NBAND * Q_BLOCK
BAND = (2 * NBAND + 1) * Q_BLOCK
C_HEADS = 8
C_KV_HEADS = 2
D_HEADS = 8
D_Q_RANK = 512
D_KV_RANK = 256
D_NOPE = 128
D_ROPE = 64
D_V = 128

A_Q = A_HEADS * 2 * A_QK_DIM
A_K = A_HEADS * 2 * A_QK_DIM
A_V = A_HEADS * A_V_DIM
A_IN = A_Q + A_K + A_V
B_Q = B_HEADS * HEAD_DIM
B_K = B_KV_HEADS * HEAD_DIM
B_V = B_KV_HEADS * HEAD_DIM
B_IN = B_Q + B_K + B_V
C_Q = C_HEADS * HEAD_DIM
C_K = C_KV_HEADS * HEAD_DIM
C_V = C_KV_HEADS * HEAD_DIM
C_IN = C_Q + C_K + C_V
D_IN = D_Q_RANK + D_KV_RANK + D_ROPE
MIX_WIDTH = A_HEADS * A_V_DIM + B_HEADS * HEAD_DIM
EVEN_IN = A_IN + B_IN + MIX_WIDTH
ODD_IN = C_IN + D_IN + MIX_WIDTH
N_EVEN = (DEPTH + 1) // 2
N_ODD = DEPTH // 2

kernel_name = "hybrid_diff_window_qknorm_mla_prefix_trunk"


def rmsnorm(x, g):
    xf = x.astype(jnp.float32)
    y = xf * lax.rsqrt(jnp.mean(xf * xf, axis=-1, keepdims=True) + EPS)
    return (y * g.astype(jnp.float32)).astype(x.dtype)


def axial_angles(n_tok, dim):
    rows = n_tok // GRID_W
    row = jnp.repeat(jnp.arange(rows), GRID_W).astype(jnp.float32)
    col = jnp.tile(jnp.arange(GRID_W), rows).astype(jnp.float32)
    n_freq = dim // 4
    inv = ROPE_BASE ** (-jnp.arange(n_freq, dtype=jnp.float32) / n_freq)
    ang = jnp.concatenate([row[:, None] * inv[None], col[:, None] * inv[None]], axis=-1)
    return jnp.cos(ang), jnp.sin(ang)


def apply_rope(x, cs):
    cos, sin = cs
    shape = (1, cos.shape[0]) + (1,) * (x.ndim - 3) + (cos.shape[1],)
    cos = cos.reshape(shape).astype(x.dtype)
    sin = sin.reshape(shape).astype(x.dtype)
    x1, x2 = jnp.split(x, 2, axis=-1)
    return jnp.concatenate([x1 * cos - x2 * sin, x1 * sin + x2 * cos], axis=-1)


def softmax_with_sink(s, sink):
    full = jnp.concatenate([s, jnp.broadcast_to(sink, s.shape[:-1] + (1,)).astype(jnp.float32)], axis=-1)
    return jax.nn.softmax(full, axis=-1)[..., :-1]


def attend(q, k, v, scale):
    b, lq, hq, dk = q.shape
    hk = k.shape[2]
    qg = q.reshape(b, lq, hk, hq // hk, dk)
    s = jnp.einsum('bqhgd,bkhd->bhgqk', qg, k).astype(jnp.float32) * scale
    p = jax.nn.softmax(s, axis=-1).astype(v.dtype)
    o = jnp.einsum('bhgqk,bkhd->bqhgd', p, v)
    return o.reshape(b, lq, hq, v.shape[-1])


def diff_attend(q1, q2, k1, k2, v, lam, scale):
    p1 = jax.nn.softmax(jnp.einsum('bqhd,bkhd->bhqk', q1, k1).astype(jnp.float32) * scale, axis=-1)
    p2 = jax.nn.softmax(jnp.einsum('bqhd,bkhd->bhqk', q2, k2).astype(jnp.float32) * scale, axis=-1)
    p = (p1 - lam * p2).astype(v.dtype)
    return jnp.einsum('bhqk,bkhd->bqhd', p, v)


def over_query_blocks(fn, *qs):
    b, s = qs[0].shape[:2]
    nb = s // Q_BLOCK
    blocks = tuple(jnp.moveaxis(q.reshape((b, nb, Q_BLOCK) + q.shape[2:]), 1, 0) for q in qs)
    out = lax.map(lambda args: fn(*args), blocks)
    return jnp.moveaxis(out, 0, 1).reshape((b, s) + out.shape[3:])


def band_mask(nb, s):
    qpos = jnp.arange(nb)[:, None, None] * Q_BLOCK + jnp.arange(Q_BLOCK)[None, :, None]
    kpos = jnp.arange(nb)[:, None, None] * Q_BLOCK - PAD + jnp.arange(BAND)[None, None, :]
    return (jnp.abs(kpos - qpos) <= WINDOW) & (kpos >= 0) & (kpos < s)


def mixer_a(u_lat, u_ctx, cs64, lam, lam_init, sub_g, with_ctx):
    def heads(u):
        b, l = u.shape[:2]
        q, k, v = jnp.split(u, [A_Q, A_Q + A_K], axis=-1)
        q = q.reshape(b, l, A_HEADS, 2 * A_QK_DIM)
        k = k.reshape(b, l, A_HEADS, 2 * A_QK_DIM)
        v = v.reshape(b, l, A_HEADS, A_V_DIM)
        return q[..., :A_QK_DIM], q[..., A_QK_DIM:], k[..., :A_QK_DIM], k[..., A_QK_DIM:], v

    q1, q2, k1, k2, v = heads(u_lat)
    q1, q2, k1, k2 = (apply_rope(t, cs64) for t in (q1, q2, k1, k2))
    cq1, cq2, ck1, ck2, cv = heads(u_ctx)
    k1a = jnp.concatenate([ck1, k1], axis=1)
    k2a = jnp.concatenate([ck2, k2], axis=1)
    va = jnp.concatenate([cv, v], axis=1)
    scale = A_QK_DIM ** -0.5

    def post(o):
        b, l = o.shape[:2]
        return (rmsnorm(o, sub_g) * (1.0 - lam_init)).reshape(b, l, A_HEADS * A_V_DIM)

    o = over_query_blocks(lambda a1, a2: diff_attend(a1, a2, k1a, k2a, va, lam, scale), q1, q2)
    y = post(o)
    yc = post(diff_attend(cq1, cq2, ck1, ck2, cv, lam, scale)) if with_ctx else None
    return y, yc


def mixer_b(u_lat, u_ctx, cs128, sink, with_ctx):
    g = B_HEADS // B_KV_HEADS

    def heads(u):
        b, l = u.shape[:2]
        q, k, v = jnp.split(u, [B_Q, B_Q + B_K], axis=-1)
        return (q.reshape(b, l, B_KV_HEADS, g, HEAD_DIM),
                k.reshape(b, l, B_KV_HEADS, HEAD_DIM),
                v.reshape(b, l, B_KV_HEADS, HEAD_DIM))

    q, k, v = heads(u_lat)
    q, k = apply_rope(q, cs128), apply_rope(k, cs128)
    cq, ck, cv = heads(u_ctx)
    b, s = q.shape[:2]
    lc = ck.shape[1]
    nb = s // Q_BLOCK
    scale = HEAD_DIM ** -0.5
    sink_hg = sink.reshape(B_KV_HEADS, g)

    def band(t):
        tp = jnp.pad(t, ((0, 0), (PAD, PAD), (0, 0), (0, 0)))
        tp = tp.reshape((b, nb + 2 * NBAND, Q_BLOCK) + t.shape[2:])
        return jnp.concatenate([tp[:, i:i + nb] for i in range(2 * NBAND + 1)], axis=2)

    qb = q.reshape(b, nb, Q_BLOCK, B_KV_HEADS, g, HEAD_DIM)
    kb, vb = band(k), band(v)
    s_win = jnp.einsum('bnqhgd,bnkhd->bnhgqk', qb, kb).astype(jnp.float32) * scale
    s_win = jnp.where(band_mask(nb, s)[None, :, None, None], s_win, NEG_INF)
    s_ctx = jnp.einsum('bnqhgd,bkhd->bnhgqk', qb, ck).astype(jnp.float32) * scale
    p = softmax_with_sink(jnp.concatenate([s_ctx, s_win], axis=-1),
                          sink_hg[None, None, :, :, None, None]).astype(v.dtype)
    o = (jnp.einsum('bnhgqk,bkhd->bnqhgd', p[..., :lc], cv)
         + jnp.einsum('bnhgqk,bnkhd->bnqhgd', p[..., lc:], vb))
    y = o.reshape(b, s, B_HEADS * HEAD_DIM)
    yc = None
    if with_ctx:
        sc = jnp.einsum('bqhgd,bkhd->bhgqk', cq, ck).astype(jnp.float32) * scale
        pc = softmax_with_sink(sc, sink_hg[None, :, :, None, None]).astype(cv.dtype)
        yc = jnp.einsum('bhgqk,bkhd->bqhgd', pc, cv).reshape(b, lc, B_HEADS * HEAD_DIM)
    return y, yc


def mixer_c(u_lat, u_ctx, cs128, q_g, k_g, with_ctx):
    def heads(u):
        b, l = u.shape[:2]
        q, k, v = jnp.split(u, [C_Q, C_Q + C_K], axis=-1)
        q = rmsnorm(q.reshape(b, l, C_HEADS, HEAD_DIM), q_g)
        k = rmsnorm(k.reshape(b, l, C_KV_HEADS, HEAD_DIM), k_g)
        return q, k, v.reshape(b, l, C_KV_HEADS, HEAD_DIM)

    q, k, v = heads(u_lat)
    q, k = apply_rope(q, cs128), apply_rope(k, cs128)
    cq, ck, cv = heads(u_ctx)
    ka = jnp.concatenate([ck, k], axis=1)
    va = jnp.concatenate([cv, v], axis=1)
    scale = HEAD_DIM ** -0.5
    b, s = q.shape[:2]
    y = over_query_blocks(lambda qb: attend(qb, ka, va, scale), q).reshape(b, s, C_HEADS * HEAD_DIM)
    yc = attend(cq, ck, cv, scale).reshape(b, ck.shape[1], C_HEADS * HEAD_DIM) if with_ctx else None
    return y, yc


def mixer_d(u_lat, u_ctx, cs64, q_a_g, kv_a_g, w_q_b, w_kv_b, with_ctx):
    def heads(u, rope):
        b, l = u.shape[:2]
        cq, ckv, kpe = jnp.split(u, [D_Q_RANK, D_Q_RANK + D_KV_RANK], axis=-1)
        q = (rmsnorm(cq, q_a_g) @ w_q_b).reshape(b, l, D_HEADS, D_NOPE + D_ROPE)
        kv = (rmsnorm(ckv, kv_a_g) @ w_kv_b).reshape(b, l, D_HEADS, D_NOPE + D_V)
        q_nope, q_pe = q[..., :D_NOPE], q[..., D_NOPE:]
        k_nope, v = kv[..., :D_NOPE], kv[..., D_NOPE:]
        kpe = kpe.reshape(b, l, 1, D_ROPE)
        if rope:
            q_pe, kpe = apply_rope(q_pe, cs64), apply_rope(kpe, cs64)
        q = jnp.concatenate([q_nope, q_pe], axis=-1)
        k = jnp.concatenate([k_nope, jnp.broadcast_to(kpe, (b, l, D_HEADS, D_ROPE))], axis=-1)
        return q, k, v

    q, k, v = heads(u_lat, True)
    cq, ck, cv = heads(u_ctx, False)
    ka = jnp.concatenate([ck, k], axis=1)
    va = jnp.concatenate([cv, v], axis=1)
    scale = (D_NOPE + D_ROPE) ** -0.5
    b, s = q.shape[:2]
    y = over_query_blocks(lambda qb: attend(qb, ka, va, scale), q).reshape(b, s, D_HEADS * D_V)
    yc = attend(cq, ck, cv, scale).reshape(b, ck.shape[1], D_HEADS * D_V) if with_ctx else None
    return y, yc


def setup_inputs(seed: int = 0) -> dict:
    key = jax.random.key(seed)
    ks = jax.random.split(key, 23)
    n = lambda k, shape, s: jax.random.normal(k, shape, jnp.float32) * s
    gain = lambda k, shape: 1.0 + 0.02 * jax.random.normal(k, shape, jnp.float32)
    return {
        "x": n(ks[0], (BATCH, SEQ, D_MODEL), 1.0),
        "c": n(ks[1], (BATCH, D_MODEL), 1.0),
        "ctx": n(ks[2], (BATCH, CTX_LEN, D_MODEL), 1.0),
        "c_ctx": n(ks[3], (D_MODEL,), 1.0),
        "w_mod": n(ks[4], (DEPTH, D_MODEL, 3 * D_MODEL), 0.5 * D_MODEL ** -0.5),
        "b_mod": n(ks[5], (DEPTH, 3 * D_MODEL), 0.01),
        "norm_g": gain(ks[6], (DEPTH, D_MODEL)),
        "w_o": n(ks[7], (DEPTH, MIX_WIDTH, D_MODEL), MIX_WIDTH ** -0.5),
        "final_g": gain(ks[8], (D_MODEL,)),
        "e_w_in": n(ks[9], (N_EVEN, D_MODEL, EVEN_IN), D_MODEL ** -0.5),
        "a_lam_q1": n(ks[10], (N_EVEN, A_QK_DIM), 0.1),
        "a_lam_k1": n(ks[11], (N_EVEN, A_QK_DIM), 0.1),
        "a_lam_q2": n(ks[12], (N_EVEN, A_QK_DIM), 0.1),
        "a_lam_k2": n(ks[13], (N_EVEN, A_QK_DIM), 0.1),
        "a_sub_g": gain(ks[14], (N_EVEN, A_V_DIM)),
        "b_sink": n(ks[15], (N_EVEN, B_HEADS), 1.0),
        "o_w_in": n(ks[16], (N_ODD, D_MODEL, ODD_IN), D_MODEL ** -0.5),
        "c_q_g": gain(ks[17], (N_ODD, HEAD_DIM)),
        "c_k_g": gain(ks[18], (N_ODD, HEAD_DIM)),
        "d_q_a_g": gain(ks[19], (N_ODD, D_Q_RANK)),
        "d_kv_a_g": gain(ks[20], (N_ODD, D_KV_RANK)),
        "d_w_q_b": n(ks[21], (N_ODD, D_Q_RANK, D_HEADS * (D_NOPE + D_ROPE)), D_Q_RANK ** -0.5),
        "d_w_kv_b": n(ks[22], (N_ODD, D_KV_RANK, D_HEADS * (D_NOPE + D_V)), D_KV_RANK ** -0.5),
    }


def reference(x, c, ctx, c_ctx, w_mod, b_mod, norm_g, w_o, final_g,
              e_w_in, a_lam_q1, a_lam_k1, a_lam_q2, a_lam_k2, a_sub_g, b_sink,
              o_w_in, c_q_g, c_k_g, d_q_a_g, d_kv_a_g, d_w_q_b, d_w_kv_b):
    s = x.shape[1]
    cs128 = axial_angles(s, HEAD_DIM)
    cs64 = axial_angles(s, A_QK_DIM)
    silu_c = jax.nn.silu(c)
    silu_cc = jax.nn.silu(c_ctx)
    cx = ctx
    for l in range(DEPTH):
        with_ctx = l < DEPTH - 1
        i = l // 2
        mod = silu_c @ w_mod[l] + b_mod[l]
        shift, scale, gate = jnp.split(mod[:, None, :], 3, axis=-1)
        cmod = silu_cc @ w_mod[l] + b_mod[l]
        cshift, cscale, cgate = jnp.split(cmod, 3)
        h = rmsnorm(x, norm_g[l]) * (1.0 + scale) + shift
        hc = rmsnorm(cx, norm_g[l]) * (1.0 + cscale) + cshift
        if l % 2 == 0:
            u = h @ e_w_in[i]
            uc = hc @ e_w_in[i]
            ua, ub, ug = jnp.split(u, [A_IN, A_IN + B_IN], axis=-1)
            uca, ucb, ucg = jnp.split(uc, [A_IN, A_IN + B_IN], axis=-1)
            lam_init = 0.8 - 0.6 * math.exp(-0.3 * l)
            lam = (jnp.exp(jnp.sum(a_lam_q1[i].astype(jnp.float32) * a_lam_k1[i].astype(jnp.float32)))
                   - jnp.exp(jnp.sum(a_lam_q2[i].astype(jnp.float32) * a_lam_k2[i].astype(jnp.float32)))
                   + lam_init)
            y1, yc1 = mixer_a(ua, uca, cs64, lam, lam_init, a_sub_g[i], with_ctx)
            y2, yc2 = mixer_b(ub, ucb, cs128, b_sink[i], with_ctx)
        else:
            u = h @ o_w_in[i]
            uc = hc @ o_w_in[i]
            ucc_, ud, ug = jnp.split(u, [C_IN, C_IN + D_IN], axis=-1)
            ucc2, ucd, ucg = jnp.split(uc, [C_IN, C_IN + D_IN], axis=-1)
            y1, yc1 = mixer_c(ucc_, ucc2, cs128, c_q_g[i], c_k_g[i], with_ctx)
            y2, yc2 = mixer_d(ud, ucd, cs64, d_q_a_g[i], d_kv_a_g[i], d_w_q_b[i], d_w_kv_b[i], with_ctx)
        y = jnp.concatenate([y1, y2], axis=-1) * jax.nn.silu(ug)
        x = x + gate * (y @ w_o[l])
        if with_ctx:
            yc = jnp.concatenate([yc1, yc2], axis=-1) * jax.nn.silu(ucg)
            cx = cx + cgate * (yc @ w_o[l])
    return rmsnorm(x, final_g)
```

```cpp
#include <hip/hip_runtime.h>
#include <hip/hip_cooperative_groups.h>
#include <cstdio>
#include <cstdint>
namespace cg = cooperative_groups;

typedef unsigned short bf16_t;
typedef short bf16x8 __attribute__((ext_vector_type(8)));
typedef short s16x4 __attribute__((ext_vector_type(4)));
typedef float f32x4 __attribute__((ext_vector_type(4)));
typedef float f32x16 __attribute__((ext_vector_type(16)));
typedef unsigned u32x4 __attribute__((ext_vector_type(4)));
typedef unsigned u32x2 __attribute__((ext_vector_type(2)));
#define LAS __attribute__((address_space(3)))

constexpr int DM = 2048, NB = 2, SEQ = 4096, CTXL = 256, TPB = SEQ + CTXL  , MTOK = NB * TPB  ;
constexpr int EVEN_N = 6656, ODD_N = 4608  , ODD_SRC = 4416;
constexpr int QD_N = 1536, KVD_N = 2560  ;
constexpr int MIXW = 3072;
constexpr float EPS = 1e-6f;
constexpr int LDS_BYTES = 131072;
constexpr int NTHREADS = 512;

constexpr size_t al256(size_t x) { return (x + 255) / 256 * 256; }
constexpr size_t WS_XW   = 0;
constexpr size_t WS_H    = WS_XW + al256((size_t)MTOK * DM * 4);
constexpr size_t WS_U    = WS_H + al256((size_t)MTOK * DM * 2);
constexpr size_t WS_QD   = WS_U + al256((size_t)MTOK * EVEN_N * 2);
constexpr size_t WS_KVD  = WS_QD + al256((size_t)MTOK * QD_N * 2);
constexpr size_t WS_MIX  = WS_KVD + al256((size_t)MTOK * KVD_N * 2);
constexpr size_t WS_WE   = WS_MIX + al256((size_t)MTOK * MIXW * 4);
constexpr size_t WS_WO_IN= WS_WE + al256((size_t)2 * EVEN_N * DM * 2);
constexpr size_t WS_WOUT = WS_WO_IN + al256((size_t)2 * ODD_N * DM * 2);
constexpr size_t WS_WQB  = WS_WOUT + al256((size_t)4 * DM * DM * 2);
constexpr size_t WS_WKVB = WS_WQB + al256((size_t)2 * QD_N * 512 * 2);
constexpr size_t WS_MOD  = WS_WKVB + al256((size_t)2 * KVD_N * 256 * 2);
constexpr size_t WS_COS128 = WS_MOD + al256((size_t)4 * 3 * 6144 * 4);
constexpr size_t WS_SIN128 = WS_COS128 + al256((size_t)SEQ * 64 * 4);
constexpr size_t WS_COS64  = WS_SIN128 + al256((size_t)SEQ * 64 * 4);
constexpr size_t WS_SIN64  = WS_COS64 + al256((size_t)SEQ * 32 * 4);
constexpr size_t WS_LAM    = WS_SIN64 + al256((size_t)SEQ * 32 * 4);
constexpr size_t WS_END    = WS_LAM + 256;

struct Params { const float* in[23]; float* out; unsigned char* ws; };
enum { I_X = 0, I_C, I_CTX, I_CCTX, I_WMOD, I_BMOD, I_NORMG, I_WO, I_FINALG, I_EWIN, I_LQ1, I_LK1, I_LQ2, I_LK2, I_SUBG, I_SINK, I_OWIN, I_CQG, I_CKG, I_DQAG, I_DKVAG, I_DWQB, I_DWKVB };

__device__ __forceinline__ unsigned cvt_pk_bf16(float lo, float hi) { unsigned r; asm volatile("v_cvt_pk_bf16_f32 %0, %1, %2" : "=v"(r) : "v"(lo), "v"(hi)); return r; }
__device__ __forceinline__ float bf_lo(unsigned w) { return __uint_as_float(w << 16); }
__device__ __forceinline__ float bf_hi(unsigned w) { return __uint_as_float(w & 0xffff0000u); }
__device__ __forceinline__ float silu_f(float x) { return x / (1.f + __expf(-x)); }
__device__ __forceinline__ int otid() { int t = threadIdx.x; asm volatile("" : "+v"(t)); return t; }

namespace pg8 {
constexpr int BM = 256, BK = 64, HALF = 128, HTB = HALF * BK * 2, STAGE_BYTES = 8 * HTB, NXCD = 8, WGM = 8;
__host__ __device__ __forceinline__ int lds_byte(int r, int c) { const int st = (r >> 4) * 2 + (c >> 5), rr = r & 15, cc = c & 31, ob = rr * 64 + cc * 2; return st * 1024 + (ob ^ (((ob >> 9) & 1) << 5)); }
__host__ __device__ __forceinline__ void stage_rc(int b, int& R, int& C) { const int st = b / 1024, sb = b % 1024, swz = sb ^ (((sb >> 9) & 1) << 5); R = (st >> 1) * 16 + swz / 64; C = (st & 1) * 32 + (swz % 64) / 2; }
__host__ __device__ __forceinline__ int perm32(int rho) { const int n = rho >> 4, i = rho & 15; return 8 * (i >> 2) + 4 * n + (i & 3); }
struct Unit { int pm, pn; };
struct Gemm { const bf16_t* A; const bf16_t* Bt; int M, N, K, lda; };
struct StaticOrder {
    int nM, nN, nwg, G, c;
    __device__ void init(int M, int N, int G_, int c_) { nM = M / BM; nN = N / BM; nwg = nM * nN; G = G_; c = c_; }
    __device__ bool next(int i, Unit& u) const {
        const long L = (long)i * G + c; if (L >= nwg) return false;
        int wgid = (int)L; { const int q = nwg / NXCD, r = nwg % NXCD, xcd = wgid % NXCD, off = wgid / NXCD; wgid = (xcd < r ? xcd * (q + 1) : r * (q + 1) + (xcd - r) * q) + off; }
        const int nig = WGM * nN, gid = wgid / nig, fm = gid * WGM, gsz = (nM - fm) < WGM ? (nM - fm) : WGM;
        u.pm = fm + ((wgid % nig) % gsz); u.pn = (wgid % nig) / gsz; return true;
    }
};
struct EpiBf16 {
    static constexpr bool PERM = true;
    bf16_t* O; int ldc;
    __device__ __forceinline__ void operator()(const f32x4 (&acc)[2][2][4][2], const Unit& u, int wr, int wc, int fr, int fq) const {
        const int row0 = u.pm * BM + wr * 64 + fr; const int col0 = u.pn * BM + wc * 32 + 8 * fq;
#pragma unroll
        for (int ai = 0; ai < 2; ++ai)
#pragma unroll
            for (int m = 0; m < 4; ++m) { bf16_t* rowp = O + (size_t)(row0 + ai * HALF + m * 16) * ldc + col0;
#pragma unroll
                for (int bj = 0; bj < 2; ++bj) { const f32x4 v0 = acc[ai][bj][m][0], v1 = acc[ai][bj][m][1];
                    u32x4 w; w.x = cvt_pk_bf16(v0[0], v0[1]); w.y = cvt_pk_bf16(v0[2], v0[3]); w.z = cvt_pk_bf16(v1[0], v1[1]); w.w = cvt_pk_bf16(v1[2], v1[3]);
                    *(u32x4*)(rowp + bj * HALF) = w; } }
    }
};
struct EpiResid {
    static constexpr bool PERM = false;
    float* X; const float* gate_l;
    __device__ __forceinline__ void operator()(const f32x4 (&acc)[2][2][4][2], const Unit& u, int wr, int wc, int fr, int fq) const {
        const int row0 = u.pm * BM + wr * 64 + fr, col0 = u.pn * BM + wc * 32 + 4 * fq;
        const int v = (u.pm % 17 == 0) ? 2 : (u.pm / 17);
        const float* gate = gate_l + v * 6144;
        f32x4 gv[2][2];
#pragma unroll
        for (int bj = 0; bj < 2; ++bj)
#pragma unroll
            for (int n = 0; n < 2; ++n) gv[bj][n] = *(const f32x4*)(gate + col0 + bj * HALF + n * 16);
#pragma unroll
        for (int ai = 0; ai < 2; ++ai)
#pragma unroll
            for (int m = 0; m < 4; ++m) { float* rowp = X + (size_t)(row0 + ai * HALF + m * 16) * DM + col0;
#pragma unroll
                for (int bj = 0; bj < 2; ++bj)
#pragma unroll
                    for (int n = 0; n < 2; ++n) { f32x4 x = *(f32x4*)(rowp + bj * HALF + n * 16); x = x + gv[bj][n] * acc[ai][bj][m][n]; *(f32x4*)(rowp + bj * HALF + n * 16) = x; } }
    }
};

template <class Epi, class Sched>
__device__ __forceinline__ void gemm_phase(LAS unsigned char* lds, const Gemm g, const Sched& S, const Epi& E) {
    const int tid = otid(), wid = __builtin_amdgcn_readfirstlane(tid >> 6), lane = tid & 63, wr = wid >> 2, wc = wid & 3, fr = lane & 15, fq = lane >> 4;
    const int K = g.K, nt = K / BK, lda = g.lda;
    unsigned voffA[2], voffB[2];
#pragma unroll
    for (int i = 0; i < 2; ++i) { int R, C; stage_rc(tid * 16 + i * 8192, R, C); const int Rb = Epi::PERM ? ((R & ~31) + perm32(R & 31)) : R;
        voffA[i] = (unsigned)(R * lda + C) * 2u; voffB[i] = (unsigned)(Rb * K + C) * 2u; }
    const size_t kstep = (size_t)(BK * 2);
    const size_t hstepA = (size_t)HALF * lda * 2, hstepB = (size_t)HALF * K * 2;
    const size_t tstepA = 2 * hstepA, tstepB = 2 * hstepB;
    const unsigned ldsw = (unsigned)wid * 1024u;
    const int aoff = lds_byte(wr * 64 + fr, fq * 8), boff = lds_byte(wc * 32 + fr, fq * 8);
#define PG8_SA(b, h) (((b) * 2 + (h)) * HTB)
#define PG8_SB(b, h) ((4 + (b) * 2 + (h)) * HTB)
#define PG8_STAGE(bufoff, gbase, voff) do { _Pragma("unroll") for (int _i = 0; _i < 2; ++_i) \
        __builtin_amdgcn_global_load_lds((const unsigned*)((const char*)(gbase) + (voff)[_i]), (LAS unsigned*)(lds + (bufoff) + ldsw + _i * 8192), 16, 0, 0); } while (0)
#define PG8_LDA(dst, b, h) do { _Pragma("unroll") for (int m = 0; m < 4; ++m) _Pragma("unroll") for (int k = 0; k < 2; ++k) dst[m][k] = *(const LAS bf16x8*)(lds + PG8_SA(b, h) + aoff + m * 2048 + k * 1024); } while (0)
#define PG8_LDB(dst, b, h) do { _Pragma("unroll") for (int n = 0; n < 2; ++n) _Pragma("unroll") for (int k = 0; k < 2; ++k) dst[n][k] = *(const LAS bf16x8*)(lds + PG8_SB(b, h) + boff + n * 2048 + k * 1024); } while (0)
#define PG8_MMA(ai, bj, At, Bt) do { __builtin_amdgcn_s_setprio(1); _Pragma("unroll") for (int m = 0; m < 4; ++m) _Pragma("unroll") for (int n = 0; n < 2; ++n) _Pragma("unroll") for (int k = 0; k < 2; ++k) \
        acc[ai][bj][m][n] = __builtin_amdgcn_mfma_f32_16x16x32_bf16(Bt[n][k], At[m][k], acc[ai][bj][m][n], 0, 0, 0); __builtin_amdgcn_s_setprio(0); } while (0)
#define PG8_WAIT_V(n) asm volatile("s_waitcnt vmcnt(" #n ")" ::: "memory")
#define PG8_WAIT_L(n) asm volatile("s_waitcnt lgkmcnt(" #n ")" ::: "memory")
#define PG8_BAR __builtin_amdgcn_s_barrier()
#define PG8_SCHED __builtin_amdgcn_sched_barrier(0)
    Unit cur, nxt; int ui = 0;
    if (!S.next(0, cur)) return;
    f32x4 acc[2][2][4][2];
#pragma unroll
    for (int a = 0; a < 2; ++a)
#pragma unroll
        for (int b = 0; b < 2; ++b)
#pragma unroll
            for (int m = 0; m < 4; ++m)
#pragma unroll
                for (int n = 0; n < 2; ++n) acc[a][b][m][n] = (f32x4){0.f, 0.f, 0.f, 0.f};
    bf16x8 At[4][2], B0[2][2], B1[2][2];
    const char* cA = (const char*)g.A + (size_t)cur.pm * tstepA; const char* cB = (const char*)g.Bt + (size_t)cur.pn * tstepB;
    PG8_STAGE(PG8_SB(0, 0), cB, voffB); PG8_STAGE(PG8_SA(0, 0), cA, voffA); PG8_STAGE(PG8_SB(0, 1), cB + hstepB, voffB); PG8_STAGE(PG8_SA(0, 1), cA + hstepA, voffA);
    if (wr == 1) PG8_BAR;
    PG8_WAIT_V(4); PG8_BAR;
    PG8_STAGE(PG8_SB(1, 0), cB + kstep, voffB); PG8_STAGE(PG8_SA(1, 0), cA + kstep, voffA); PG8_STAGE(PG8_SB(1, 1), cB + hstepB + kstep, voffB);
    PG8_WAIT_V(6); PG8_BAR;
    for (;;) {
        const bool has_next = S.next(ui + 1, nxt);
        const char* nA = has_next ? (const char*)g.A + (size_t)nxt.pm * tstepA : cA; const char* nB = has_next ? (const char*)g.Bt + (size_t)nxt.pn * tstepB : cB;
        for (int t = 0; t < nt; t += 2) {
            const bool last = (t == nt - 2);
            const char* a1 = cA + (size_t)(t + 1) * kstep;
            const char* a2 = last ? nA : cA + (size_t)(t + 2) * kstep; const char* b2 = last ? nB : cB + (size_t)(t + 2) * kstep;
            const char* a3 = a2 + kstep; const char* b3 = b2 + kstep;
            PG8_LDB(B0, 0, 0); PG8_SCHED; PG8_LDA(At, 0, 0); PG8_STAGE(PG8_SA(1, 1), a1 + hstepA, voffA);
            PG8_WAIT_L(8); PG8_BAR; PG8_WAIT_L(0); PG8_MMA(0, 0, At, B0); PG8_BAR; PG8_SCHED;
            PG8_LDB(B1, 0, 1); PG8_STAGE(PG8_SB(0, 0), b2, voffB);
            PG8_BAR; PG8_WAIT_L(0); PG8_MMA(0, 1, At, B1); PG8_BAR;
            PG8_LDA(At, 0, 1); PG8_STAGE(PG8_SA(0, 0), a2, voffA);
            PG8_BAR; PG8_WAIT_L(0); PG8_MMA(1, 0, At, B0); PG8_BAR; PG8_SCHED;
            PG8_STAGE(PG8_SB(0, 1), b2 + hstepB, voffB);
            PG8_WAIT_V(6); PG8_BAR; PG8_MMA(1, 1, At, B1); PG8_BAR;
            PG8_LDB(B0, 1, 0); PG8_SCHED; PG8_LDA(At, 1, 0); PG8_STAGE(PG8_SA(0, 1), a2 + hstepA, voffA);
            PG8_WAIT_L(8); PG8_BAR; PG8_WAIT_L(0); PG8_MMA(0, 0, At, B0); PG8_BAR; PG8_SCHED;
            PG8_LDB(B1, 1, 1); PG8_STAGE(PG8_SB(1, 0), b3, voffB);
            PG8_BAR; PG8_WAIT_L(0); PG8_MMA(0, 1, At, B1); PG8_BAR;
            PG8_LDA(At, 1, 1); PG8_STAGE(PG8_SA(1, 0), a3, voffA);
            PG8_BAR; PG8_WAIT_L(0); PG8_MMA(1, 0, At, B0); PG8_BAR; PG8_SCHED;
            PG8_STAGE(PG8_SB(1, 1), b3 + hstepB, voffB);
            PG8_WAIT_V(6); PG8_BAR; PG8_MMA(1, 1, At, B1); PG8_BAR;
        }
        E(acc, cur, wr, wc, fr, fq);
        if (!has_next) break;
#pragma unroll
        for (int a = 0; a < 2; ++a)
#pragma unroll
            for (int b = 0; b < 2; ++b)
#pragma unroll
                for (int m = 0; m < 4; ++m)
#pragma unroll
                    for (int n = 0; n < 2; ++n) acc[a][b][m][n] = (f32x4){0.f, 0.f, 0.f, 0.f};
        cur = nxt; cA = nA; cB = nB; ++ui;
    }
    PG8_WAIT_V(0);
    if (wr == 0) PG8_BAR;
    PG8_BAR;
#undef PG8_SA
#undef PG8_SB
#undef PG8_STAGE
#undef PG8_LDA
#undef PG8_LDB
#undef PG8_MMA
#undef PG8_WAIT_V
#undef PG8_WAIT_L
#undef PG8_BAR
#undef PG8_SCHED
}
}

namespace att {
constexpr int NW = 8, QBLK = 32, KVBLK = 64;
constexpr float THR = 8.f;
constexpr int SHM_V = KVBLK * 128 * 2;
constexpr int K_OFF = 2 * SHM_V, WS_OFF = K_OFF + 2 * KVBLK * 192 * 2, QX_OFF = WS_OFF + NW * 64 * 4;
#define SBAR() __builtin_amdgcn_sched_barrier(0)
__device__ __forceinline__ int crow(int r, int hi) { return (r & 3) + 8 * (r >> 2) + 4 * hi; }
template <int DQK> struct SC { };
template <> struct SC<64>  { static constexpr float SCALE = 0.125f; };
template <> struct SC<128> { static constexpr float SCALE = 0.088388347648318440f; };
template <> struct SC<192> { static constexpr float SCALE = 0.072168783648703220f; };

template <int DQK>
__device__ __forceinline__ void partialSM(f32x16& p0, f32x16& p1, float& m_reg, float& mn, float& alpha, bool msk, int kq0, int hi) {
  constexpr float SCALE = SC<DQK>::SCALE;
  constexpr float C = SCALE * 1.4426950408889634f;
  if (msk) {
#pragma unroll
    for (int r = 0; r < 16; ++r) { const int d0 = kq0 + crow(r, hi);
      if ((unsigned)(d0 + 128) > 256u) p0[r] = -1e30f;
      if ((unsigned)(d0 + 32 + 128) > 256u) p1[r] = -1e30f; }
  }
  float pmax = p0[0];
#pragma unroll
  for (int r = 1; r < 16; ++r) pmax = fmaxf(pmax, p0[r]);
#pragma unroll
  for (int r = 0; r < 16; ++r) pmax = fmaxf(pmax, p1[r]);
  { auto rr = __builtin_amdgcn_permlane32_swap(__float_as_uint(pmax), __float_as_uint(pmax), false, false);
    pmax = fmaxf(__uint_as_float(rr[0]), __uint_as_float(rr[1])); }
  if (__builtin_expect(__all(pmax - m_reg <= THR / SCALE), 1)) { mn = m_reg; alpha = 1.f; }
  else { mn = fmaxf(m_reg, pmax); alpha = __builtin_amdgcn_exp2f((m_reg - mn) * C); m_reg = mn; }
  const float mnC = -mn * C;
#pragma unroll
  for (int r = 0; r < 16; ++r) p0[r] = fmaf(p0[r], C, mnC);
#pragma unroll
  for (int r = 0; r < 16; ++r) p1[r] = fmaf(p1[r], C, mnC);
#pragma unroll
  for (int r = 0; r < 16; ++r) p0[r] = __builtin_amdgcn_exp2f(p0[r]);
}
__device__ __forceinline__ void finishSM(f32x16& p0, f32x16& p1, float alpha, float& l_reg, bf16x8& pa0, bf16x8& pa1, bf16x8& pa2, bf16x8& pa3) {
#pragma unroll
  for (int r = 0; r < 16; ++r) p1[r] = __builtin_amdgcn_exp2f(p1[r]);
  float ps = 0;
#pragma unroll
  for (int r = 0; r < 16; ++r) ps += p0[r];
#pragma unroll
  for (int r = 0; r < 16; ++r) ps += p1[r];
  { auto rr = __builtin_amdgcn_permlane32_swap(__float_as_uint(ps), __float_as_uint(ps), false, false);
    ps = __uint_as_float(rr[0]) + __uint_as_float(rr[1]); }
  l_reg = l_reg * alpha + ps;
#define PK4(P, BASE, OUT) do { unsigned a0 = cvt_pk_bf16(P[BASE + 0], P[BASE + 1]), a1 = cvt_pk_bf16(P[BASE + 2], P[BASE + 3]);   \
    unsigned b0 = cvt_pk_bf16(P[BASE + 4], P[BASE + 5]), b1 = cvt_pk_bf16(P[BASE + 6], P[BASE + 7]);                              \
    auto r0 = __builtin_amdgcn_permlane32_swap(a0, b0, false, false); auto r1 = __builtin_amdgcn_permlane32_swap(a1, b1, false, false); \
    u32x4 w = {r0[0], r1[0], r0[1], r1[1]}; OUT = *reinterpret_cast<bf16x8*>(&w); } while (0)
  PK4(p0, 0, pa0); PK4(p0, 8, pa1); PK4(p1, 0, pa2); PK4(p1, 8, pa3);
#undef PK4
}
template <int DQK>
__device__ __forceinline__ void qkt(f32x16& p0, f32x16& p1, const char* Ks, const bf16x8* qr, const char* qx, int r32, int hi) {
  constexpr int RB = DQK * 2, NQR = DQK == 192 ? 8 : DQK / 16;
  p0 = f32x16{}; p1 = f32x16{};
  const int sw = (r32 & 7) << 4;
#pragma unroll
  for (int d0 = 0; d0 < DQK / 16; ++d0) { const int cb = (d0 * 16 + hi * 8) * 2;
    bf16x8 b0 = *reinterpret_cast<const bf16x8*>(Ks + r32 * RB + (cb ^ sw));
    bf16x8 b1 = *reinterpret_cast<const bf16x8*>(Ks + (32 + r32) * RB + (cb ^ sw));
    bf16x8 q;
    if (d0 < NQR) q = qr[d0 < NQR ? d0 : 0]; else q = *reinterpret_cast<const bf16x8*>(qx + ((((d0 - NQR) * 2 + hi) * 16) ^ sw));
    p0 = __builtin_amdgcn_mfma_f32_32x32x16_bf16(b0, q, p0, 0, 0, 0);
    p1 = __builtin_amdgcn_mfma_f32_32x32x16_bf16(b1, q, p1, 0, 0, 0); }
}
__device__ __forceinline__ int v_st(int k, int c) { const int kk = (k & ~0xC) | ((k & 4) << 1) | ((k & 8) >> 1); return ((kk >> 3) * 4 + (c >> 5)) * 512 + ((kk & 7) * 32 + (c & 31)) * 2; }
__device__ __forceinline__ int v_rd_base(int lane) { return ((lane & 3) << 3) | (((lane >> 2) & 3) << 6) | (((lane >> 4) & 1) << 5) | (((lane >> 5) & 1) << 8); }
constexpr int v_rd_off(int d0, int ks, int half) { return d0 * 512 + ks * 4096 + half * 2048; }
template <int OFF> __device__ __forceinline__ s16x4 tr_read(int vb) {
  s16x4 r; asm volatile("ds_read_b64_tr_b16 %0, %1 offset:%2" : "=&v"(r) : "v"(vb), "i"(OFF) : "memory"); return r;
}
template <int D0> __device__ __forceinline__ void pv_one(f32x16& od, int vb, bf16x8 pa0, bf16x8 pa1, bf16x8 pa2, bf16x8 pa3) {
  const s16x4 l0 = tr_read<v_rd_off(D0, 0, 0)>(vb), h0 = tr_read<v_rd_off(D0, 0, 1)>(vb), l1 = tr_read<v_rd_off(D0, 1, 0)>(vb), h1 = tr_read<v_rd_off(D0, 1, 1)>(vb);
  const s16x4 l2 = tr_read<v_rd_off(D0, 2, 0)>(vb), h2 = tr_read<v_rd_off(D0, 2, 1)>(vb), l3 = tr_read<v_rd_off(D0, 3, 0)>(vb), h3 = tr_read<v_rd_off(D0, 3, 1)>(vb);
  asm volatile("s_waitcnt lgkmcnt(0)" ::: "memory"); SBAR();
#define PK(L, H) (bf16x8){L[0], L[1], L[2], L[3], H[0], H[1], H[2], H[3]}
  od = __builtin_amdgcn_mfma_f32_32x32x16_bf16(pa0, PK(l0, h0), od, 0, 0, 0);
  od = __builtin_amdgcn_mfma_f32_32x32x16_bf16(pa1, PK(l1, h1), od, 0, 0, 0);
  od = __builtin_amdgcn_mfma_f32_32x32x16_bf16(pa2, PK(l2, h2), od, 0, 0, 0);
  od = __builtin_amdgcn_mfma_f32_32x32x16_bf16(pa3, PK(l3, h3), od, 0, 0, 0);
#undef PK
}
__device__ __forceinline__ void pv_d0(f32x16* o, int vb, bf16x8 pa0, bf16x8 pa1, bf16x8 pa2, bf16x8 pa3) {
  pv_one<0>(o[0], vb, pa0, pa1, pa2, pa3); pv_one<1>(o[1], vb, pa0, pa1, pa2, pa3); pv_one<2>(o[2], vb, pa0, pa1, pa2, pa3); pv_one<3>(o[3], vb, pa0, pa1, pa2, pa3);
}

template <int DQK, int SDEPTH>
__device__ __forceinline__ void attn_body(const bf16_t* __restrict__ Qb, int ldq, const bf16_t* __restrict__ Kh, const bf16_t* __restrict__ Vh, int ldk,
                                          float* __restrict__ Ob, int ldo, int NT, int lo, bool win, int qpos0, float sink_l2, char* lds) {
  constexpr int RB = DQK * 2, SHM_K = KVBLK * RB, CPR = DQK / 8, NKC = DQK / 64, NQR = DQK == 192 ? 8 : DQK / 16;
  constexpr float C = SC<DQK>::SCALE * 1.4426950408889634f;
  const int tid = otid(), wid = tid >> 6, lane = tid & 63, r32 = lane & 31, hi = lane >> 5;
  char* V_lds = lds; char* K_lds = lds + K_OFF;
  float* ws = (float*)(lds + WS_OFF) + wid * 64; float* li_l = ws; float* al_l = ws + 32;
  float m_reg = -1e30f, l_reg = 0; f32x16 o[4] = {}; bf16x8 qr[NQR];
  const bf16_t* Qw = Qb + (long)(wid * QBLK + r32) * ldq + hi * 8;
#pragma unroll
  for (int d0 = 0; d0 < NQR; ++d0) qr[d0] = *reinterpret_cast<const bf16x8*>(Qw + d0 * 16);
  char* qx = lds + QX_OFF + wid * 4096 + r32 * 128;
#pragma unroll
  for (int d0 = NQR; d0 < DQK / 16; ++d0) *reinterpret_cast<bf16x8*>(qx + ((((d0 - NQR) * 2 + hi) * 16) ^ ((r32 & 7) << 4))) = *reinterpret_cast<const bf16x8*>(Qw + d0 * 16);
  const int sr = tid >> 4, sc = (tid & 15) * 8, vst0 = v_st(sr, sc), vst1 = v_st(32 + sr, sc);
  int kgo[NKC], klo[NKC];
#pragma unroll
  for (int c = 0; c < NKC; ++c) { const int id = tid + 512 * c, kr = id / CPR, kc = (id % CPR) * 8; kgo[c] = kr * ldk + kc; klo[c] = kr * RB + ((kc * 2) ^ ((kr & 7) << 4)); }
  const int vb0 = (int)(uintptr_t)V_lds + v_rd_base(lane);
  const int qmy = qpos0 + wid * QBLK + r32 + 256;
  struct { bf16x8 vs0, vs1; bf16x8 ks[NKC]; } sr_[1];
#define KROW(t) ((t) * KVBLK + ((win && (t) >= 4) ? lo : 0))
#define SLOAD(i, t) do { const int k0_ = KROW(t); sr_[i].vs0 = *reinterpret_cast<const bf16x8*>(&Vh[(long)(k0_ + sr) * ldk + sc]); sr_[i].vs1 = *reinterpret_cast<const bf16x8*>(&Vh[(long)(k0_ + 32 + sr) * ldk + sc]); \
    _Pragma("unroll") for (int c_ = 0; c_ < NKC; ++c_) sr_[i].ks[c_] = *reinterpret_cast<const bf16x8*>(&Kh[(long)k0_ * ldk + kgo[c_]]); } while (0)
#define SWRITE(b, i) do { *(bf16x8*)(V_lds + (b) * SHM_V + vst0) = sr_[i].vs0; *(bf16x8*)(V_lds + (b) * SHM_V + vst1) = sr_[i].vs1; \
    _Pragma("unroll") for (int c_ = 0; c_ < NKC; ++c_) *(bf16x8*)(K_lds + (b) * SHM_K + klo[c_]) = sr_[i].ks[c_]; } while (0)
#define SWAIT() do { if constexpr (SDEPTH == 1) asm volatile("s_waitcnt vmcnt(0)" ::: "memory"); else if constexpr (NKC == 1) asm volatile("s_waitcnt vmcnt(3)" ::: "memory"); else if constexpr (NKC == 2) asm volatile("s_waitcnt vmcnt(4)" ::: "memory"); else asm volatile("s_waitcnt vmcnt(5)" ::: "memory"); } while (0)
#define RESC(a) do { if (__any((a) < 1.f)) { if (hi == 0) al_l[r32] = (a); asm volatile("s_waitcnt lgkmcnt(0)" ::: "memory"); \
    _Pragma("unroll") for (int d = 0; d < 4; ++d) _Pragma("unroll") for (int r = 0; r < 16; ++r) o[d][r] *= al_l[crow(r, hi)]; } } while (0)
#define PSM(P0, P1, MN, AL, t) partialSM<DQK>(P0, P1, m_reg, MN, AL, win && (t) >= 4, KROW(t) - qmy, hi)
  f32x16 p0, p1; float mn, al; bf16x8 pa0, pa1, pa2, pa3;
  SLOAD(0, 0); asm volatile("s_waitcnt vmcnt(0)" ::: "memory"); SWRITE(0, 0); __syncthreads();
  for (int j = 0; j < NT; ++j) {
    const int cur = j & 1; const bool more = j + 1 < NT;
    if (more) SLOAD(0, j + 1);
    SBAR();
    qkt<DQK>(p0, p1, K_lds + cur * SHM_K, qr, qx, r32, hi);
    PSM(p0, p1, mn, al, j);
    RESC(al);
    finishSM(p0, p1, al, l_reg, pa0, pa1, pa2, pa3); SBAR();
    pv_d0(o, vb0 + cur * SHM_V, pa0, pa1, pa2, pa3);
    if (more) SWRITE(cur ^ 1, 0);
    __syncthreads();
  }
  l_reg += __builtin_amdgcn_exp2f(sink_l2 - m_reg * C);
  if (hi == 0) li_l[r32] = l_reg; asm volatile("s_waitcnt lgkmcnt(0)" ::: "memory");
  float rli[16];
#pragma unroll
  for (int r = 0; r < 16; ++r) rli[r] = __builtin_amdgcn_rcpf(li_l[crow(r, hi)]);
  float* Ow = Ob + (long)(wid * QBLK) * ldo;
#pragma unroll
  for (int r = 0; r < 16; ++r) { const int orow = crow(r, hi);
#pragma unroll
    for (int d0 = 0; d0 < 4; ++d0) Ow[(long)orow * ldo + d0 * 32 + r32] = o[d0][r] * rli[r]; }
#undef KROW
#undef SLOAD
#undef SWRITE
#undef SWAIT
#undef RESC
#undef PSM
}
}

__device__ __forceinline__ void unpack8(u32x4 w, float (&f)[8]) {
  f[0] = bf_lo(w.x); f[1] = bf_hi(w.x); f[2] = bf_lo(w.y); f[3] = bf_hi(w.y); f[4] = bf_lo(w.z); f[5] = bf_hi(w.z); f[6] = bf_lo(w.w); f[7] = bf_hi(w.w);
}
__device__ __forceinline__ u32x4 pack8(const float (&f)[8]) {
  u32x4 w; w.x = cvt_pk_bf16(f[0], f[1]); w.y = cvt_pk_bf16(f[2], f[3]); w.z = cvt_pk_bf16(f[4], f[5]); w.w = cvt_pk_bf16(f[6], f[7]); return w;
}
__device__ __forceinline__ void ld8f(const float* p, float (&f)[8]) { const f32x4 a = *(const f32x4*)p, b = *(const f32x4*)(p + 4); f[0] = a.x; f[1] = a.y; f[2] = a.z; f[3] = a.w; f[4] = b.x; f[5] = b.y; f[6] = b.z; f[7] = b.w; }
__device__ __forceinline__ float wave_sum(float v) {
#pragma unroll
  for (int o = 1; o < 64; o <<= 1) v += __shfl_xor(v, o);
  return v;
}
__device__ __forceinline__ void sincos_acc(float ang, float& c, float& s) {
  const double a = (double)ang; const double n = rint(a * 0.15915494309189533577); const double r = a - n * 6.283185307179586476925;
  const double r2 = r * r; double ts = r, tc = 1.0, ss = 0.0, cc = 0.0;
#pragma unroll
  for (int k = 1; k <= 13; ++k) { ss += ts; cc += tc; tc *= -r2 / (double)((2 * k - 1) * (2 * k)); ts *= -r2 / (double)((2 * k) * (2 * k + 1)); }
  s = (float)ss; c = (float)cc;
}

__device__ __forceinline__ void p0_transpose_item(const float* W, int Nsrc, int K, bf16_t* WT, int k0, int n_dst0, int n_src0, float* scr, int lane) {
  if (n_src0 >= 0) {
#pragma unroll 8
    for (int i = 0; i < 32; ++i) { const int kk = 2 * i + (lane >> 5); scr[kk * 33 + (lane & 31)] = W[(size_t)(k0 + kk) * Nsrc + n_src0 + (lane & 31)]; }
  } else {
#pragma unroll 8
    for (int i = 0; i < 32; ++i) { const int kk = 2 * i + (lane >> 5); scr[kk * 33 + (lane & 31)] = 0.f; }
  }
  asm volatile("s_waitcnt lgkmcnt(0)" ::: "memory");
  const int c = lane & 7;
#pragma unroll
  for (int j = 0; j < 4; ++j) { const int n = (lane >> 3) + 8 * j; const float* s = scr + (8 * c) * 33 + n;
    u32x4 o; o.x = cvt_pk_bf16(s[0 * 33], s[1 * 33]); o.y = cvt_pk_bf16(s[2 * 33], s[3 * 33]); o.z = cvt_pk_bf16(s[4 * 33], s[5 * 33]); o.w = cvt_pk_bf16(s[6 * 33], s[7 * 33]);
    *(u32x4*)(WT + (size_t)(n_dst0 + n) * K + k0 + 8 * c) = o; }
  asm volatile("s_waitcnt lgkmcnt(0)" ::: "memory");
}

__device__ __forceinline__ void phase_p0(const Params& P, char* lds) {
  const int tid = otid(), lane = tid & 63, wave = tid >> 6;
  unsigned char* ws = P.ws;
  const int G = gridDim.x, bx = blockIdx.x;
  {
    float* sv = (float*)lds; float* red = sv + 3 * 2048;
    float* mod = (float*)(ws + WS_MOD);
    if (bx < 192) {
      for (int i = tid; i < 6144; i += NTHREADS) { const int v = i >> 11, k = i & 2047; const float x = v < 2 ? P.in[I_C][v * 2048 + k] : P.in[I_CCTX][k]; sv[i] = silu_f(x); }
    }
    __syncthreads();
    for (int unit = bx; unit < 192; unit += G) {
      const int l = unit / 48, nb = unit % 48, cgi = lane & 31, ks = lane >> 5;
      const float* W = P.in[I_WMOD] + (size_t)l * 2048 * 6144 + nb * 128 + cgi * 4;
      f32x4 a0 = {0, 0, 0, 0}, a1 = {0, 0, 0, 0}, a2 = {0, 0, 0, 0};
#pragma unroll 8
      for (int i = 0; i < 128; ++i) { const int k = wave * 256 + ks + 2 * i; const f32x4 wv = *(const f32x4*)(W + (size_t)k * 6144);
        a0 += sv[k] * wv; a1 += sv[2048 + k] * wv; a2 += sv[4096 + k] * wv; }
      const int pi = wave * 2 + ks;
      *(f32x4*)(red + (pi * 3 + 0) * 128 + cgi * 4) = a0; *(f32x4*)(red + (pi * 3 + 1) * 128 + cgi * 4) = a1; *(f32x4*)(red + (pi * 3 + 2) * 128 + cgi * 4) = a2;
      __syncthreads();
      if (tid < 384) { const int v = tid >> 7, n = tid & 127; float s = P.in[I_BMOD][l * 6144 + nb * 128 + n];
#pragma unroll
        for (int p = 0; p < 16; ++p) s += red[(p * 3 + v) * 128 + n];
        mod[(size_t)(l * 3 + v) * 6144 + nb * 128 + n] = s; }
      __syncthreads();
    }
  }
  if (bx == G - 1 && tid < 2) {
    const int i = tid; float s1 = 0.f, s2 = 0.f;
    for (int k = 0; k < 64; ++k) { s1 += P.in[I_LQ1][i * 64 + k] * P.in[I_LK1][i * 64 + k]; s2 += P.in[I_LQ2][i * 64 + k] * P.in[I_LK2][i * 64 + k]; }
    const float lam_init = i == 0 ? 0.2f : 0.47071301834358416f;
    ((float*)(ws + WS_LAM))[i] = expf(s1) - expf(s2) + lam_init;
  }
  {
    float* c128 = (float*)(ws + WS_COS128); float* s128 = (float*)(ws + WS_SIN128); float* c64 = (float*)(ws + WS_COS64); float* s64 = (float*)(ws + WS_SIN64);
    const int gt = bx * NTHREADS + tid, NT_ = G * NTHREADS;
    for (int w = gt; w < SEQ * 96; w += NT_) {
      const int s = w / 96, j = w % 96; const int row = s >> 6, col = s & 63;
      if (j < 64) { const int f = j & 31; const float inv = powf(10000.f, -(float)f / 32.f); const float ang = (float)(j < 32 ? row : col) * inv; float c_, s_; sincos_acc(ang, c_, s_); c128[s * 64 + j] = c_; s128[s * 64 + j] = s_; }
      else { const int jj = j - 64, f = jj & 15; const float inv = powf(10000.f, -(float)f / 16.f); const float ang = (float)(jj < 16 ? row : col) * inv; float c_, s_; sincos_acc(ang, c_, s_); c64[s * 32 + jj] = c_; s64[s * 32 + jj] = s_; }
    }
  }
  {
    f32x4* xw = (f32x4*)(ws + WS_XW);
    const size_t gt = (size_t)bx * NTHREADS + tid, NT_ = (size_t)G * NTHREADS;
    for (size_t w = gt; w < (size_t)MTOK * 512; w += NT_) {
      const int m = (int)(w >> 9), c4 = (int)(w & 511); const int b = m / TPB, t = m % TPB;
      const float* src = t < CTXL ? P.in[I_CTX] + ((size_t)(b * CTXL + t)) * DM : P.in[I_X] + ((size_t)(b * SEQ + (t - CTXL))) * DM;
      xw[w] = *(const f32x4*)(src + c4 * 4);
    }
  }
  {
    float* scr = (float*)(lds + wave * 8448);
    __syncthreads();
    const int gw = bx * 8 + wave, NGW = G * 8;
    constexpr int I_E = 32 * 208, I_O = 32 * 144, I_W = 32 * 64, I_Q = 8 * 48, I_KV = 4 * 80;
    constexpr int NITEMS = 2 * I_E + 2 * I_O + 4 * I_W + 2 * I_Q + 2 * I_KV;
    for (int it = gw; it < NITEMS; it += NGW) {
      int r = it;
      if (r < 2 * I_E) { const int i = r / I_E; r %= I_E; const int kb = r / 208, nb = r % 208;
        p0_transpose_item(P.in[I_EWIN] + (size_t)i * DM * EVEN_N, EVEN_N, DM, (bf16_t*)(ws + WS_WE) + (size_t)i * EVEN_N * DM, kb * 64, nb * 32, nb * 32, scr, lane); continue; }
      r -= 2 * I_E;
      if (r < 2 * I_O) { const int i = r / I_O; r %= I_O; const int kb = r / 144, nb = r % 144; const int nd = nb * 32; const int ns = nd < 2368 ? nd : (nd < 2560 ? -1 : nd - 192);
        p0_transpose_item(P.in[I_OWIN] + (size_t)i * DM * ODD_SRC, ODD_SRC, DM, (bf16_t*)(ws + WS_WO_IN) + (size_t)i * ODD_N * DM, kb * 64, nd, ns, scr, lane); continue; }
      r -= 2 * I_O;
      if (r < 4 * I_W) { const int i = r / I_W; r %= I_W; const int kb = r / 64, nb = r % 64;
        p0_transpose_item(P.in[I_WO] + (size_t)i * DM * DM, DM, DM, (bf16_t*)(ws + WS_WOUT) + (size_t)i * DM * DM, kb * 64, nb * 32, nb * 32, scr, lane); continue; }
      r -= 4 * I_W;
      if (r < 2 * I_Q) { const int i = r / I_Q; r %= I_Q; const int kb = r / 48, nb = r % 48;
        p0_transpose_item(P.in[I_DWQB] + (size_t)i * 512 * QD_N, QD_N, 512, (bf16_t*)(ws + WS_WQB) + (size_t)i * QD_N * 512, kb * 64, nb * 32, nb * 32, scr, lane); continue; }
      r -= 2 * I_Q;
      { const int i = r / I_KV; r %= I_KV; const int kb = r / 80, nb = r % 80; const int nd = nb * 32, h = nd / 320, j = nd % 320;
        const int ns = j < 128 ? h * 256 + j : (j < 192 ? -1 : h * 256 + 128 + (j - 192));
        p0_transpose_item(P.in[I_DWKVB] + (size_t)i * 256 * 2048, 2048, 256, (bf16_t*)(ws + WS_WKVB) + (size_t)i * KVD_N * 256, kb * 64, nd, ns, scr, lane); }
    }
  }
}

__device__ __forceinline__ void phase_norm(const Params& P, int l) {
  const int tid = otid(), lane = tid & 63, wave = tid >> 6;
  const float* xw = (const float*)(P.ws + WS_XW); bf16_t* h = (bf16_t*)(P.ws + WS_H);
  const float* mod = (const float*)(P.ws + WS_MOD) + (size_t)l * 3 * 6144; const float* g = P.in[I_NORMG] + l * DM;
  for (int m = blockIdx.x * 8 + wave; m < MTOK; m += gridDim.x * 8) {
    const int b = m / TPB, t = m % TPB, v = t < CTXL ? 2 : b;
    const float* xr = xw + (size_t)m * DM + lane * 4; const float* sh = mod + v * 6144 + lane * 4; const float* scp = sh + 2048;
    f32x4 x[8]; float ss = 0.f;
#pragma unroll
    for (int j = 0; j < 8; ++j) { x[j] = *(const f32x4*)(xr + 256 * j); ss += (x[j].x * x[j].x + x[j].y * x[j].y) + (x[j].z * x[j].z + x[j].w * x[j].w); }
    const float rstd = rsqrtf(wave_sum(ss) * (1.f / DM) + EPS);
#pragma unroll
    for (int j = 0; j < 8; ++j) { const f32x4 gg = *(const f32x4*)(g + lane * 4 + 256 * j), s1 = *(const f32x4*)(scp + 256 * j), s0 = *(const f32x4*)(sh + 256 * j);
      const f32x4 y = (x[j] * rstd) * gg * (1.f + s1) + s0;
      u32x2 w; w.x = cvt_pk_bf16(y.x, y.y); w.y = cvt_pk_bf16(y.z, y.w);
      *(u32x2*)(h + (size_t)m * DM + lane * 4 + 256 * j) = w; }
  }
}

__device__ __forceinline__ void rope8(float (&x1)[8], float (&x2)[8], const float* cosp, const float* sinp) {
  float c[8], s[8]; ld8f(cosp, c); ld8f(sinp, s);
#pragma unroll
  for (int i = 0; i < 8; ++i) { const float a = x1[i], b = x2[i]; x1[i] = a * c[i] - b * s[i]; x2[i] = a * s[i] + b * c[i]; }
}

__device__ __forceinline__ void phase_prep_even(const Params& P) {
  bf16_t* u = (bf16_t*)(P.ws + WS_U);
  const float* c128 = (const float*)(P.ws + WS_COS128); const float* s128 = (const float*)(P.ws + WS_SIN128); const float* c64 = (const float*)(P.ws + WS_COS64); const float* s64 = (const float*)(P.ws + WS_SIN64);
  const int gt = blockIdx.x * NTHREADS + otid(), NT_ = gridDim.x * NTHREADS;
  for (int w = gt; w < NB * SEQ * 208; w += NT_) {
    const int lr = w / 208, cp = w % 208, b = lr >> 12, s = lr & 4095; const size_t m = (size_t)b * TPB + CTXL + s;
    int col1, dist; const float *cp_, *sp_;
    if (cp < 128) { const int hu = cp >> 2, j = cp & 3; col1 = hu * 64 + j * 8; dist = 32; cp_ = c64 + s * 32 + j * 8; sp_ = s64 + s * 32 + j * 8; }
    else { const int c2 = cp - 128, hd = c2 >> 3, j = c2 & 7; col1 = 3072 + hd * 128 + j * 8; dist = 64; cp_ = c128 + s * 64 + j * 8; sp_ = s128 + s * 64 + j * 8; }
    bf16_t* p1 = u + m * EVEN_N + col1; bf16_t* p2 = p1 + dist;
    float x1[8], x2[8]; unpack8(*(const u32x4*)p1, x1); unpack8(*(const u32x4*)p2, x2);
    rope8(x1, x2, cp_, sp_);
    *(u32x4*)p1 = pack8(x1); *(u32x4*)p2 = pack8(x2);
  }
}

__device__ __forceinline__ void phase_prep_odd1(const Params& P, int i) {
  bf16_t* u = (bf16_t*)(P.ws + WS_U);
  const float* c128 = (const float*)(P.ws + WS_COS128); const float* s128 = (const float*)(P.ws + WS_SIN128);
  const int gt = blockIdx.x * NTHREADS + otid(), NT_ = gridDim.x * NTHREADS;
  for (int w = gt; w < MTOK * 10 * 8; w += NT_) {
    const int unit = w >> 3, j = w & 7, m = unit / 10, hd = unit % 10, t = m % TPB;
    const float* g = (hd < 8 ? P.in[I_CQG] : P.in[I_CKG]) + i * 128;
    bf16_t* p1 = u + (size_t)m * ODD_N + hd * 128 + j * 8; bf16_t* p2 = p1 + 64;
    float x1[8], x2[8]; unpack8(*(const u32x4*)p1, x1); unpack8(*(const u32x4*)p2, x2);
    float ss = 0.f;
#pragma unroll
    for (int k = 0; k < 8; ++k) ss += x1[k] * x1[k] + x2[k] * x2[k];
    ss += __shfl_xor(ss, 1); ss += __shfl_xor(ss, 2); ss += __shfl_xor(ss, 4);
    const float rstd = rsqrtf(ss * (1.f / 128.f) + EPS);
    float g1[8], g2[8]; ld8f(g + j * 8, g1); ld8f(g + 64 + j * 8, g2);
#pragma unroll
    for (int k = 0; k < 8; ++k) { x1[k] = x1[k] * rstd * g1[k]; x2[k] = x2[k] * rstd * g2[k]; }
    if (t >= CTXL) { const int s = t - CTXL; rope8(x1, x2, c128 + s * 64 + j * 8, s128 + s * 64 + j * 8); }
    *(u32x4*)p1 = pack8(x1); *(u32x4*)p2 = pack8(x2);
  }
  const int tid2 = otid(), lane = tid2 & 63, wave = tid2 >> 6;
  const float* gq = P.in[I_DQAG] + i * 512; const float* gkv = P.in[I_DKVAG] + i * 256;
  for (int m = blockIdx.x * 8 + wave; m < MTOK; m += gridDim.x * 8) {
    { bf16_t* p = u + (size_t)m * ODD_N + 1536 + lane * 8; float x[8]; unpack8(*(const u32x4*)p, x); float ss = 0.f;
#pragma unroll
      for (int k = 0; k < 8; ++k) ss += x[k] * x[k];
      const float rstd = rsqrtf(wave_sum(ss) * (1.f / 512.f) + EPS); float gg[8]; ld8f(gq + lane * 8, gg);
#pragma unroll
      for (int k = 0; k < 8; ++k) x[k] = x[k] * rstd * gg[k];
      *(u32x4*)p = pack8(x); }
    { const int l2 = lane & 31; bf16_t* p = u + (size_t)m * ODD_N + 2048 + l2 * 8; float x[8]; unpack8(*(const u32x4*)p, x); float ss = 0.f;
#pragma unroll
      for (int k = 0; k < 8; ++k) ss += x[k] * x[k];
#pragma unroll
      for (int o = 1; o < 32; o <<= 1) ss += __shfl_xor(ss, o);
      const float rstd = rsqrtf(ss * (1.f / 256.f) + EPS); float gg[8]; ld8f(gkv + l2 * 8, gg);
#pragma unroll
      for (int k = 0; k < 8; ++k) x[k] = x[k] * rstd * gg[k];
      if (lane < 32) *(u32x4*)p = pack8(x); }
  }
}

__device__ __forceinline__ void phase_prep_odd2(const Params& P) {
  const bf16_t* u = (const bf16_t*)(P.ws + WS_U); bf16_t* qd = (bf16_t*)(P.ws + WS_QD); bf16_t* kvd = (bf16_t*)(P.ws + WS_KVD);
  const float* c64 = (const float*)(P.ws + WS_COS64); const float* s64 = (const float*)(P.ws + WS_SIN64);
  const int gt = blockIdx.x * NTHREADS + otid(), NT_ = gridDim.x * NTHREADS;
  for (int w = gt; w < MTOK * 36; w += NT_) {
    const int m = w / 36, cp = w % 36, t = m % TPB; const bool lat = t >= CTXL; const int s = t - CTXL;
    if (cp < 32) {
      if (!lat) continue;
      const int hd = cp >> 2, j = cp & 3; bf16_t* p1 = qd + (size_t)m * QD_N + hd * 192 + 128 + j * 8; bf16_t* p2 = p1 + 32;
      float x1[8], x2[8]; unpack8(*(const u32x4*)p1, x1); unpack8(*(const u32x4*)p2, x2);
      rope8(x1, x2, c64 + s * 32 + j * 8, s64 + s * 32 + j * 8);
      *(u32x4*)p1 = pack8(x1); *(u32x4*)p2 = pack8(x2);
    } else {
      const int j = cp - 32; const bf16_t* p1 = u + (size_t)m * ODD_N + 2304 + j * 8; const bf16_t* p2 = p1 + 32;
      float x1[8], x2[8]; unpack8(*(const u32x4*)p1, x1); unpack8(*(const u32x4*)p2, x2);
      if (lat) rope8(x1, x2, c64 + s * 32 + j * 8, s64 + s * 32 + j * 8);
      const u32x4 o1 = pack8(x1), o2 = pack8(x2);
#pragma unroll
      for (int hd = 0; hd < 8; ++hd) { bf16_t* d = kvd + (size_t)m * KVD_N + hd * 320 + 128 + j * 8; *(u32x4*)d = o1; *(u32x4*)(d + 32) = o2; }
    }
  }
}

__device__ __forceinline__ void phase_post(const Params& P, int l) {
  const int tid = otid(), lane = tid & 63, wave = tid >> 6; const bool even = (l & 1) == 0; const int i = l >> 1;
  const float* mix = (const float*)(P.ws + WS_MIX); const bf16_t* u = (const bf16_t*)(P.ws + WS_U); bf16_t* y = (bf16_t*)(P.ws + WS_H);
  const int ldu = even ? EVEN_N : ODD_N, goff = even ? 4608 : 2560;
  const float lam = even ? ((const float*)(P.ws + WS_LAM))[i] : 0.f; const float one_m = even ? (i == 0 ? 0.8f : (1.f - 0.47071301834358416f)) : 0.f;
  const float* subg = P.in[I_SUBG] + i * 128;
  const bool skip_ctx = (l == 3);
  for (int m = blockIdx.x * 8 + wave; m < MTOK; m += gridDim.x * 8) {
    if (skip_ctx && (m % TPB) < CTXL) continue;
    const float* mr = mix + (size_t)m * MIXW + lane * 4; const bf16_t* ur = u + (size_t)m * ldu + goff + lane * 4; bf16_t* yr = y + (size_t)m * DM + lane * 4;
#pragma unroll
    for (int j = 0; j < 8; ++j) {
      f32x4 v = *(const f32x4*)(mr + 256 * j);
      if (even && j < 4) {
        const f32x4 v2 = *(const f32x4*)(mr + 2048 + 256 * j); v = v - lam * v2;
        float ss = (v.x * v.x + v.y * v.y) + (v.z * v.z + v.w * v.w);
#pragma unroll
        for (int o = 1; o < 32; o <<= 1) ss += __shfl_xor(ss, o);
        const float rstd = rsqrtf(ss * (1.f / 128.f) + EPS);
        const f32x4 gg = *(const f32x4*)(subg + (lane & 31) * 4);
        v = v * rstd * gg * one_m;
      }
      const u32x2 gw = *(const u32x2*)(ur + 256 * j);
      const float g0 = bf_lo(gw.x), g1 = bf_hi(gw.x), g2 = bf_lo(gw.y), g3 = bf_hi(gw.y);
      u32x2 o; o.x = cvt_pk_bf16(v.x * silu_f(g0), v.y * silu_f(g1)); o.y = cvt_pk_bf16(v.z * silu_f(g2), v.w * silu_f(g3));
      *(u32x2*)(yr + 256 * j) = o;
    }
  }
}

__device__ __forceinline__ void phase_final(const Params& P) {
  const int tid = otid(), lane = tid & 63, wave = tid >> 6;
  const float* xw = (const float*)(P.ws + WS_XW); const float* g = P.in[I_FINALG];
  for (int r = blockIdx.x * 8 + wave; r < NB * SEQ; r += gridDim.x * 8) {
    const int b = r >> 12, s = r & 4095; const float* xr = xw + ((size_t)b * TPB + CTXL + s) * DM + lane * 4; float* orow = P.out + (size_t)r * DM + lane * 4;
    f32x4 x[8]; float ss = 0.f;
#pragma unroll
    for (int j = 0; j < 8; ++j) { x[j] = *(const f32x4*)(xr + 256 * j); ss += (x[j].x * x[j].x + x[j].y * x[j].y) + (x[j].z * x[j].z + x[j].w * x[j].w); }
    const float rstd = rsqrtf(wave_sum(ss) * (1.f / DM) + EPS);
#pragma unroll
    for (int j = 0; j < 8; ++j) { const f32x4 gg = *(const f32x4*)(g + lane * 4 + 256 * j); *(f32x4*)(orow + 256 * j) = (x[j] * rstd) * gg; }
  }
}

#ifndef ASD
#define ASD 1
#endif
__device__ __forceinline__ int xcd_perm(int id) { const int r = id >> 8, c = id & 255; const int p = (((c & 7) * 2 + ((c >> 3) >> 4)) << 4) + ((c >> 3) & 15); return (r << 8) + p; }

__device__ __forceinline__ void phase_attn(const Params& P, int l, char* lds) {
  const bool even = (l & 1) == 0; const int i = l >> 1; const bool with_ctx = l < 3;
  const bf16_t* u = (const bf16_t*)(P.ws + WS_U); const bf16_t* qd = (const bf16_t*)(P.ws + WS_QD); const bf16_t* kvd = (const bf16_t*)(P.ws + WS_KVD);
  float* mix = (float*)(P.ws + WS_MIX);
  const int nlat = even ? 768 : 512, nall = with_ctx ? (even ? 816 : 544) : nlat;
  for (int it = blockIdx.x; it < nall; it += gridDim.x) {
    int type, b, hd, qb;
    if (it < nlat) {
      const int id = xcd_perm(it);
      if (even) { if (id < 512) { type = 0; const int g = id >> 4; b = g >> 4; hd = g & 15; qb = (id & 15) + 1; } else { type = 1; const int g = (id - 512) >> 4; b = g >> 3; hd = g & 7; qb = (id & 15) + 1; } }
      else { const int g = (id & 255) >> 4; type = id < 256 ? 2 : 3; b = g >> 3; hd = g & 7; qb = (id & 15) + 1; }
    } else {
      const int id = it - nlat; qb = 0;
      if (even) { if (id < 32) { type = 0; b = id >> 4; hd = id & 15; } else { type = 1; b = (id - 32) >> 3; hd = (id - 32) & 7; } }
      else { type = id < 16 ? 2 : 3; b = (id & 15) >> 3; hd = id & 7; }
    }
    const size_t row0 = (size_t)b * TPB + (size_t)qb * 256, rowb = (size_t)b * TPB;
    int NT = qb == 0 ? 4 : 68, lo = 0, q0 = 0, ldq, ldk; bool win = false; float sink = -1e30f;
    const bf16_t *Qp, *Kp, *Vp; float* Op;
    if (type == 0) { const int h = hd >> 1, half = hd & 1; ldq = EVEN_N; ldk = EVEN_N;
      Qp = u + row0 * EVEN_N + h * 128 + half * 64; Kp = u + rowb * EVEN_N + 1024 + h * 128 + half * 64; Vp = u + rowb * EVEN_N + 2048 + h * 128; Op = mix + row0 * MIXW + (half ? 2048 : 0) + h * 128;
    } else if (type == 1) { ldq = EVEN_N; ldk = EVEN_N; win = true;
      if (qb > 0) { q0 = (qb - 1) * 256; lo = q0 >= 128 ? q0 - 128 : 0; const int hk = (q0 + 384) < SEQ ? (q0 + 384) : SEQ; NT = 4 + (hk - lo) / 64; }
      sink = P.in[I_SINK][i * 8 + hd] * 1.4426950408889634f;
      Qp = u + row0 * EVEN_N + 3072 + hd * 128; Kp = u + rowb * EVEN_N + 4096 + (hd >> 2) * 128; Vp = u + rowb * EVEN_N + 4352 + (hd >> 2) * 128; Op = mix + row0 * MIXW + 1024 + hd * 128;
    } else if (type == 2) { ldq = ODD_N; ldk = ODD_N;
      Qp = u + row0 * ODD_N + hd * 128; Kp = u + rowb * ODD_N + 1024 + (hd >> 2) * 128; Vp = u + rowb * ODD_N + 1280 + (hd >> 2) * 128; Op = mix + row0 * MIXW + hd * 128;
    } else { ldq = QD_N; ldk = KVD_N;
      Qp = qd + row0 * QD_N + hd * 192; Kp = kvd + rowb * KVD_N + hd * 320; Vp = Kp + 192; Op = mix + row0 * MIXW + 1024 + hd * 128;
    }
    __syncthreads();
    if (type == 0) att::attn_body<64, ASD>(Qp, ldq, Kp, Vp, ldk, Op, MIXW, NT, lo, win, q0, sink, lds);
    else if (type == 3) att::attn_body<192, ASD>(Qp, ldq, Kp, Vp, ldk, Op, MIXW, NT, lo, win, q0, sink, lds);
    else att::attn_body<128, ASD>(Qp, ldq, Kp, Vp, ldk, Op, MIXW, NT, lo, win, q0, sink, lds);
  }
}

__global__ void __launch_bounds__(NTHREADS) mega_fwd(Params P) {
  extern __shared__ __attribute__((aligned(16))) unsigned char lds_raw[];
  cg::grid_group grid = cg::this_grid();
  char* lds = (char*)lds_raw; LAS unsigned char* ldsl = (LAS unsigned char*)lds_raw;
  unsigned char* ws = P.ws;
  const int G = gridDim.x, bx = blockIdx.x;

  phase_p0(P, lds);
  grid.sync();
  for (int l = 0; l < 4; ++l) {
    const bool even = (l & 1) == 0; const int i = l >> 1;
    phase_norm(P, l);
    grid.sync();
    {
      const int N = even ? EVEN_N : ODD_N;
      const bf16_t* Wt = even ? (const bf16_t*)(ws + WS_WE) + (size_t)i * EVEN_N * DM : (const bf16_t*)(ws + WS_WO_IN) + (size_t)i * ODD_N * DM;
      pg8::Gemm g{(const bf16_t*)(ws + WS_H), Wt, MTOK, N, DM, DM}; pg8::StaticOrder S; S.init(MTOK, N, G, bx);
      pg8::EpiBf16 E{(bf16_t*)(ws + WS_U), N};
      pg8::gemm_phase<pg8::EpiBf16, pg8::StaticOrder>(ldsl, g, S, E);
    }
    grid.sync();
    if (even) { phase_prep_even(P); }
    else {
      phase_prep_odd1(P, i);
      grid.sync();
      for (int k = 0; k < 2; ++k) {
        const int N = k == 0 ? QD_N : KVD_N, K = k == 0 ? 512 : 256;
        const bf16_t* A = (const bf16_t*)(ws + WS_U) + (k == 0 ? 1536 : 2048);
        const bf16_t* Wt = k == 0 ? (const bf16_t*)(ws + WS_WQB) + (size_t)i * QD_N * 512 : (const bf16_t*)(ws + WS_WKVB) + (size_t)i * KVD_N * 256;
        pg8::Gemm g{A, Wt, MTOK, N, K, ODD_N}; pg8::StaticOrder S; S.init(MTOK, N, G, bx);
        pg8::EpiBf16 E{(bf16_t*)(ws + (k == 0 ? WS_QD : WS_KVD)), N};
        pg8::gemm_phase<pg8::EpiBf16, pg8::StaticOrder>(ldsl, g, S, E);
      }
      grid.sync();
      phase_prep_odd2(P);
    }
    grid.sync();
    phase_attn(P, l, lds);
    grid.sync();
    phase_post(P, l);
    grid.sync();
    {
      pg8::Gemm g{(const bf16_t*)(ws + WS_H), (const bf16_t*)(ws + WS_WOUT) + (size_t)l * DM * DM, MTOK, DM, DM, DM}; pg8::StaticOrder S; S.init(MTOK, DM, G, bx);
      pg8::EpiResid E{(float*)(ws + WS_XW), (const float*)(ws + WS_MOD) + (size_t)l * 3 * 6144 + 4096};
      pg8::gemm_phase<pg8::EpiResid, pg8::StaticOrder>(ldsl, g, S, E);
    }
    grid.sync();
  }
  phase_final(P);
}

extern "C" void kernel_launch(void* const* d_in, const int* in_sizes, int n_in, void* d_out, int out_size, void* d_ws, size_t ws_size, hipStream_t stream) {
  static int grid_blocks = 0;
  if (grid_blocks == 0) {
    if (n_in != 23 || in_sizes[0] != NB * SEQ * DM || out_size != NB * SEQ * DM || ws_size < WS_END) {
      fprintf(stderr, "kernel_launch: shape mismatch: n_in %d in0 %d out %d ws %zu (need %zu)\n", n_in, n_in > 0 ? in_sizes[0] : -1, out_size, ws_size, (size_t)WS_END); grid_blocks = -1; return; }
    int dev = 0, cus = 0, per_cu = 0;
    hipGetDevice(&dev); hipDeviceGetAttribute(&cus, hipDeviceAttributeMultiprocessorCount, dev);
    if (hipFuncSetAttribute((const void*)mega_fwd, hipFuncAttributeMaxDynamicSharedMemorySize, LDS_BYTES) != hipSuccess) { fprintf(stderr, "kernel_launch: hipFuncSetAttribute failed\n"); grid_blocks = -1; return; }
    if (hipOccupancyMaxActiveBlocksPerMultiprocessor(&per_cu, (const void*)mega_fwd, NTHREADS, LDS_BYTES) != hipSuccess || per_cu < 1) { fprintf(stderr, "kernel_launch: occupancy query gave %d\n", per_cu); per_cu = 1; (void)hipGetLastError(); }
    grid_blocks = cus * 1;
    fprintf(stderr, "kernel_launch: cus %d per_cu %d grid %d\n", cus, per_cu, grid_blocks);
  }
  if (grid_blocks < 0) return;
  Params p{};
  for (int k = 0; k < 23; ++k) p.in[k] = (const float*)d_in[k];
  p.out = (float*)d_out; p.ws = (unsigned char*)d_ws;
  void* args[] = {&p};
  hipError_t e = hipLaunchCooperativeKernel((const void*)mega_fwd, dim3(grid_blocks), dim3(NTHREADS), args, LDS_BYTES, stream);
  if (e != hipSuccess) fprintf(stderr, "kernel_launch: cooperative launch failed: %s (grid %d)\n", hipGetErrorString(e), grid_blocks);
}
```

```cpp
#include <hip/hip_runtime.h>
#include <hip/hip_cooperative_groups.h>
#include <cstdio>
#include <cstdint>
namespace cg = cooperative_groups;

typedef unsigned short bf16_t;
typedef short bf16x8 __attribute__((ext_vector_type(8)));
typedef short s16x4 __attribute__((ext_vector_type(4)));
typedef float f32x4 __attribute__((ext_vector_type(4)));
typedef float f32x16 __attribute__((ext_vector_type(16)));
typedef unsigned u32x4 __attribute__((ext_vector_type(4)));
typedef unsigned u32x2 __attribute__((ext_vector_type(2)));
#define LAS __attribute__((address_space(3)))
#define XCD_BAR_WORDS 3456

constexpr int DM = 2048, NB = 2, SEQ = 4096, CTXL = 256, TPB = SEQ + CTXL  , MTOK = NB * TPB  ;
constexpr int EVEN_N = 6656, ODD_N = 4608  , ODD_SRC = 4416;
constexpr int QD_N = 1536, KVD_N = 2560  ;
constexpr int MIXW = 3072;
constexpr float EPS = 1e-6f;
constexpr int LDS_MAIN = 131072;
constexpr int LDS_BYTES = LDS_MAIN + 256 + 2048;
constexpr int NTHREADS = 512;

constexpr size_t al256(size_t x) { return (x + 255) / 256 * 256; }
constexpr size_t WS_XW   = 0;
constexpr size_t WS_H    = WS_XW + al256((size_t)MTOK * DM * 4);
constexpr size_t WS_U    = WS_H + al256((size_t)MTOK * DM * 2);
constexpr size_t WS_QD   = WS_U + al256((size_t)MTOK * EVEN_N * 2);
constexpr size_t WS_KVD  = WS_QD + al256((size_t)MTOK * QD_N * 2);
constexpr size_t WS_MIX  = WS_KVD + al256((size_t)MTOK * KVD_N * 2);
constexpr size_t WS_WE   = WS_MIX + al256((size_t)MTOK * MIXW * 4);
constexpr size_t WS_WO_IN= WS_WE + al256((size_t)2 * EVEN_N * DM * 2);
constexpr size_t WS_WOUT = WS_WO_IN + al256((size_t)2 * ODD_N * DM * 2);
constexpr size_t WS_WQB  = WS_WOUT + al256((size_t)4 * DM * DM * 2);
constexpr size_t WS_WKVB = WS_WQB + al256((size_t)2 * QD_N * 512 * 2);
constexpr size_t WS_MOD  = WS_WKVB + al256((size_t)2 * KVD_N * 256 * 2);
constexpr size_t WS_COS128 = WS_MOD + al256((size_t)4 * 3 * 6144 * 4);
constexpr size_t WS_SIN128 = WS_COS128 + al256((size_t)SEQ * 64 * 4);
constexpr size_t WS_COS64  = WS_SIN128 + al256((size_t)SEQ * 64 * 4);
constexpr size_t WS_SIN64  = WS_COS64 + al256((size_t)SEQ * 32 * 4);
constexpr size_t WS_LAM    = WS_SIN64 + al256((size_t)SEQ * 32 * 4);
constexpr size_t WS_PART   = WS_LAM + 256;
constexpr size_t WS_BAR    = WS_PART + al256((size_t)8 * 512 * DM * 4);
constexpr size_t WS_END    = WS_BAR + al256((size_t)XCD_BAR_WORDS * 4);

struct Params { const float* in[23]; float* out; unsigned char* ws; };
enum { I_X = 0, I_C, I_CTX, I_CCTX, I_WMOD, I_BMOD, I_NORMG, I_WO, I_FINALG, I_EWIN, I_LQ1, I_LK1, I_LQ2, I_LK2, I_SUBG, I_SINK, I_OWIN, I_CQG, I_CKG, I_DQAG, I_DKVAG, I_DWQB, I_DWKVB };

__device__ __forceinline__ unsigned cvt_pk_bf16(float lo, float hi) { unsigned r; asm volatile("v_cvt_pk_bf16_f32 %0, %1, %2" : "=v"(r) : "v"(lo), "v"(hi)); return r; }
__device__ __forceinline__ float bf_lo(unsigned w) { return __uint_as_float(w << 16); }
__device__ __forceinline__ float bf_hi(unsigned w) { return __uint_as_float(w & 0xffff0000u); }
__device__ __forceinline__ float silu_f(float x) { return x / (1.f + __expf(-x)); }
__device__ __forceinline__ int otid() { int t = threadIdx.x; asm volatile("" : "+v"(t)); return t; }

#define XB_TMO      128
#define XB_XCNT(j)  (256  + 64 * (j))
#define XB_XSUB(j)  (1280 + 64 * (j))
#define XB_XGEN(j)  (2304 + 64 * (j))
#define XB_TOP      3328
#define XB_TOPGEN   3392
#define XB_SPIN_CAP (1u << 18)

__device__ __forceinline__ unsigned xb_ld(unsigned* p)              { return __hip_atomic_load(p, __ATOMIC_RELAXED, __HIP_MEMORY_SCOPE_AGENT); }
__device__ __forceinline__ unsigned xb_add(unsigned* p, unsigned v) { return __hip_atomic_fetch_add(p, v, __ATOMIC_RELAXED, __HIP_MEMORY_SCOPE_AGENT); }
__device__ __forceinline__ unsigned xb_xcc_id() { return (unsigned)__builtin_amdgcn_s_getreg((3 << 11) | 20) & 0xFu; }
#define XB_SPIN(cond, bar) do { unsigned _sp = 0; while (cond) { __builtin_amdgcn_s_sleep(1); \
    if ((++_sp & 255u) == 0u) { if (xb_ld(&(bar)[XB_TMO])) break; if (_sp > XB_SPIN_CAP) { atomicAdd(&(bar)[XB_TMO], 1u); break; } } } } while (0)

struct XcdBarrier {
    unsigned* bar; unsigned x;
    volatile LAS unsigned* st;
};

__device__ __forceinline__ XcdBarrier xcd_barrier_post(unsigned* bar, volatile LAS unsigned* st) {
    XcdBarrier b; b.bar = bar; b.x = xb_xcc_id(); b.st = st;
    if (threadIdx.x == 0) (void)xb_add(&bar[XB_XCNT(b.x)], 1u);
    return b;
}
__device__ __forceinline__ void xcd_barrier_complete(unsigned* bar, unsigned x, unsigned& nloc, unsigned& nx) {
    const unsigned G = gridDim.x * gridDim.y * gridDim.z;
    unsigned sum, cnt, mine, sp = 0u;
    for (;;) {
        sum = 0u; cnt = 0u; mine = 0u;
#pragma unroll
        for (unsigned j = 0; j < 16; ++j) { const unsigned c = xb_ld(&bar[XB_XCNT(j)]); sum += c; cnt += (c > 0u) ? 1u : 0u; mine = (j == x) ? c : mine; }
        if (sum == G) break;
        __builtin_amdgcn_s_sleep(1);
        if ((++sp & 255u) == 0u) { if (xb_ld(&bar[XB_TMO])) break; if (sp > XB_SPIN_CAP) { atomicAdd(&bar[XB_TMO], 1u); break; } }
    }
    nloc = mine > 0u ? mine : 1u; nx = cnt > 0u ? cnt : 1u;
}

__device__ __forceinline__ void xcd_barrier(const XcdBarrier& b) {
    asm volatile("s_waitcnt vmcnt(0)" ::: "memory");
    __syncthreads();
    if (threadIdx.x == 0) {
        unsigned* bar = b.bar;
        __builtin_amdgcn_s_waitcnt(0);
        unsigned nloc = b.st[0], nx = b.st[1];
        if (nloc == 0u) { xcd_barrier_complete(bar, b.x, nloc, nx); b.st[0] = nloc; b.st[1] = nx; }
        const unsigned old = xb_add(&bar[XB_XSUB(b.x)], 1u);
        const unsigned gen = old / nloc;
        if (old + 1u == (gen + 1u) * nloc) {
            __builtin_amdgcn_fence(__ATOMIC_RELEASE, "agent");
            asm volatile("s_waitcnt vmcnt(0)" ::: "memory");
            const unsigned og = xb_add(&bar[XB_TOP], 1u);
            const unsigned tg = og / nx;
            if (og + 1u == (tg + 1u) * nx) xb_add(&bar[XB_TOPGEN], 1u);
            else XB_SPIN(xb_ld(&bar[XB_TOPGEN]) == tg, bar);
            __builtin_amdgcn_fence(__ATOMIC_ACQUIRE, "agent");
            xb_add(&bar[XB_XGEN(b.x)], 1u);
            asm volatile("s_waitcnt vmcnt(0)" ::: "memory");
        } else {
            XB_SPIN(xb_ld(&bar[XB_XGEN(b.x)]) == gen, bar);
            __builtin_amdgcn_fence(__ATOMIC_ACQUIRE, "agent");
            asm volatile("s_waitcnt vmcnt(0)" ::: "memory");
        }
    }
    __syncthreads();
}


namespace pg8 {
constexpr int BM = 256, BK = 64, HALF = 128, HTB = HALF * BK * 2, STAGE_BYTES = 8 * HTB, NXCD = 8, WGM = 8;
__host__ __device__ __forceinline__ int lds_byte(int r, int c) { const int st = (r >> 4) * 2 + (c >> 5), rr = r & 15, cc = c & 31, ob = rr * 64 + cc * 2; return st * 1024 + (ob ^ (((ob >> 9) & 1) << 5)); }
__host__ __device__ __forceinline__ void stage_rc(int b, int& R, int& C) { const int st = b / 1024, sb = b % 1024, swz = sb ^ (((sb >> 9) & 1) << 5); R = (st >> 1) * 16 + swz / 64; C = (st & 1) * 32 + (swz % 64) / 2; }
__host__ __device__ __forceinline__ int perm32(int rho) { const int n = rho >> 4, i = rho & 15; return 8 * (i >> 2) + 4 * n + (i & 3); }
struct Unit { int pm, pn, kt0, nkt; };
struct Gemm { const bf16_t* A; const bf16_t* Bt; int M, N, K, lda; };
struct StaticOrder {
    int nM, nN, nwg, G, c, nkt;
    __device__ void init(int M, int N, int K, int G_, int c_) { nM = M / BM; nN = N / BM; nwg = nM * nN; G = G_; c = c_; nkt = K / BK; }
    __device__ bool next(int i, Unit& u) const {
        const long L = (long)i * G + c; if (L >= nwg) return false;
        u.kt0 = 0; u.nkt = nkt;
        int wgid = (int)L; { const int q = nwg / NXCD, r = nwg % NXCD, xcd = wgid % NXCD, off = wgid / NXCD; wgid = (xcd < r ? xcd * (q + 1) : r * (q + 1) + (xcd - r) * q) + off; }
        const int nig = WGM * nN, gid = wgid / nig, fm = gid * WGM, gsz = (nM - fm) < WGM ? (nM - fm) : WGM;
        u.pm = fm + ((wgid % nig) % gsz); u.pn = (wgid % nig) / gsz; return true;
    }
};
struct OutOrder {
    int G, c, nseg;
    __device__ void init(int G_, int c_, bool with_ctx) { G = G_; c = c_; nseg = with_ctx ? 384 : 256; }
    __device__ bool next(int i, Unit& u) const {
        const int s = i * G + c; if (s >= nseg) return false;
        if (s < 256) { const int x = s & 7, j = s >> 3, lt = 4 * x + (j >> 3); u.pm = lt < 16 ? lt + 1 : lt + 2; u.pn = j & 7; u.kt0 = 0; u.nkt = 32; }
        else { const int cs = s - 256, cu = cs >> 3; u.pm = (cu >> 3) * 17; u.pn = cu & 7; u.kt0 = 4 * (cs & 7); u.nkt = 4; }
        return true;
    }
};
struct EpiBf16 {
    static constexpr bool PERM = true;
    bf16_t* O; int ldc;
    __device__ __forceinline__ void prefetch(const Unit&, int, LAS unsigned char*) const {}
    int skip_gap;
    int rope_en; const float *c64, *s64, *c128, *s128;
    __device__ __forceinline__ void operator()(const f32x4 (&acc)[2][2][4][2], const Unit& u, int wr, int wc, int fr, int fq) const {
        const int row0 = u.pm * BM + wr * 64 + fr;
        int mode = 0; if (rope_en) { if (u.pn >= 4 && u.pn < 8) mode = 1; else if (u.pn == 16) mode = 2; }
        if (mode == 0) {
            const int col0 = u.pn * BM + wc * 32 + 8 * fq;
#pragma unroll
            for (int ai = 0; ai < 2; ++ai)
#pragma unroll
                for (int m = 0; m < 4; ++m) { bf16_t* rowp = O + (size_t)(row0 + ai * HALF + m * 16) * ldc + col0;
#pragma unroll
                    for (int bj = 0; bj < 2; ++bj) { const f32x4 v0 = acc[ai][bj][m][0], v1 = acc[ai][bj][m][1];
                        u32x4 w; w.x = cvt_pk_bf16(v0[0], v0[1]); w.y = cvt_pk_bf16(v0[2], v0[3]); w.z = cvt_pk_bf16(v1[0], v1[1]); w.w = cvt_pk_bf16(v1[2], v1[3]);
                        const int rr = (col0 + bj * HALF) % 320;
                        if (!(skip_gap && rr >= 128 && rr < 192)) *(u32x4*)(rowp + bj * HALF) = w; } }
        } else {
            const bool lat = (u.pm % 17) != 0; const int bb = u.pm / 17;
            const int i0 = mode == 1 ? 8 * fq : (wc & 1) * 32 + 8 * fq, dist = mode == 1 ? 32 : 64, tst = mode == 1 ? 32 : 64;
            const int colA = u.pn * BM + (mode == 1 ? wc * 64 : (wc >> 1) * 128) + i0;
            const int nf = tst >> 1; float irev[8];
#pragma unroll
            for (int j = 0; j < 8; ++j) irev[j] = __builtin_amdgcn_exp2f(-(float)((i0 + j) & (nf - 1)) * (13.287712379549449f / (float)nf)) * 0.15915494309189535f;
            const bool use_col = (i0 & nf) != 0;
#pragma unroll
            for (int ai = 0; ai < 2; ++ai)
#pragma unroll
                for (int m = 0; m < 4; ++m) { const int row = row0 + ai * HALF + m * 16; bf16_t* rowp = O + (size_t)row * ldc + colA;
                    f32x4 a0 = acc[ai][0][m][0], a1 = acc[ai][0][m][1], b0 = acc[ai][1][m][0], b1 = acc[ai][1][m][1];
                    if (lat) { const int sp = row - bb * 4352 - 256; const float pos = (float)(use_col ? (sp & 63) : (sp >> 6));
                        f32x4 c0, c1, s0, s1;
#pragma unroll
                        for (int j = 0; j < 4; ++j) { const float r0 = __builtin_amdgcn_fractf(pos * irev[j]), r1 = __builtin_amdgcn_fractf(pos * irev[4 + j]);
                            c0[j] = __builtin_amdgcn_cosf(r0); s0[j] = __builtin_amdgcn_sinf(r0); c1[j] = __builtin_amdgcn_cosf(r1); s1[j] = __builtin_amdgcn_sinf(r1); }
                        const f32x4 y0 = a0 * c0 - b0 * s0, y1 = a1 * c1 - b1 * s1, z0 = a0 * s0 + b0 * c0, z1 = a1 * s1 + b1 * c1; a0 = y0; a1 = y1; b0 = z0; b1 = z1; }
                    u32x4 w; w.x = cvt_pk_bf16(a0[0], a0[1]); w.y = cvt_pk_bf16(a0[2], a0[3]); w.z = cvt_pk_bf16(a1[0], a1[1]); w.w = cvt_pk_bf16(a1[2], a1[3]);
                    *(u32x4*)rowp = w;
                    w.x = cvt_pk_bf16(b0[0], b0[1]); w.y = cvt_pk_bf16(b0[2], b0[3]); w.z = cvt_pk_bf16(b1[0], b1[1]); w.w = cvt_pk_bf16(b1[2], b1[3]);
                    *(u32x4*)(rowp + dist) = w; }
        }
    }
};
struct EpiResid {
    static constexpr bool PERM = false;
    float* X; const float* gate_l; float* part; const float* Rin;
    __device__ __forceinline__ void prefetch(const Unit& u, int tid, LAS unsigned char* sink) const {
        if (u.nkt < 32) return;
#pragma unroll
        for (int j = 0; j < 4; ++j) { const int line = tid * 4 + j, r = line >> 3, sg = line & 7; const size_t row = (size_t)u.pm * BM + r;
            const float* p = (Rin ? Rin + (row - (size_t)256 * (u.pm / 17 + 1)) * DM : X + row * DM) + u.pn * BM + sg * 32;
            __builtin_amdgcn_global_load_lds((const unsigned*)p, (LAS unsigned*)sink, 4, 0, 0); }
    }
    __device__ __forceinline__ void operator()(const f32x4 (&acc)[2][2][4][2], const Unit& u, int wr, int wc, int fr, int fq) const {
        const int row0 = u.pm * BM + wr * 64 + fr, col0 = u.pn * BM + wc * 32 + 4 * fq;
        const int v = (u.pm % 17 == 0) ? 2 : (u.pm / 17);
        const float* gate = gate_l + v * 6144;
        f32x4 gv[2][2];
#pragma unroll
        for (int bj = 0; bj < 2; ++bj)
#pragma unroll
            for (int n = 0; n < 2; ++n) gv[bj][n] = *(const f32x4*)(gate + col0 + bj * HALF + n * 16);
#pragma unroll
        for (int ai = 0; ai < 2; ++ai)
#pragma unroll
            for (int m = 0; m < 4; ++m) { const size_t row = (size_t)(row0 + ai * HALF + m * 16); float* rowp = X + row * DM + col0;
                const float* rinp = Rin ? Rin + (row - (size_t)256 * (u.pm / 17 + 1)) * DM + col0 : rowp;
#pragma unroll
                for (int bj = 0; bj < 2; ++bj)
#pragma unroll
                    for (int n = 0; n < 2; ++n) {
                        const f32x4 d = gv[bj][n] * acc[ai][bj][m][n]; float* p = rowp + bj * HALF + n * 16;
                        if (u.nkt < 32) { float* q = part + ((size_t)(u.kt0 >> 2) * 512 + (u.pm ? 256 : 0) + (wr * 64 + fr + ai * HALF + m * 16)) * DM + col0 + bj * HALF + n * 16; *(f32x4*)q = d; }
                        else { f32x4 x = *(const f32x4*)(rinp + bj * HALF + n * 16); x = x + d; *(f32x4*)p = x; } } }
    }
};

template <class Epi, class Sched>
__device__ __forceinline__ void gemm_phase(LAS unsigned char* lds, const Gemm g, const Sched& S, const Epi& E) {
    const int tid = otid(), wid = __builtin_amdgcn_readfirstlane(tid >> 6), lane = tid & 63, wr = wid >> 2, wc = wid & 3, fr = lane & 15, fq = lane >> 4;
    const int K = g.K, lda = g.lda;
    unsigned voffA[2], voffB[2];
#pragma unroll
    for (int i = 0; i < 2; ++i) { int R, C; stage_rc(tid * 16 + i * 8192, R, C); const int Rb = Epi::PERM ? ((R & ~31) + perm32(R & 31)) : R;
        voffA[i] = (unsigned)(R * lda + C) * 2u; voffB[i] = (unsigned)(Rb * K + C) * 2u; }
    const size_t kstep = (size_t)(BK * 2);
    const size_t hstepA = (size_t)HALF * lda * 2, hstepB = (size_t)HALF * K * 2;
    const size_t tstepA = 2 * hstepA, tstepB = 2 * hstepB;
    const unsigned ldsw = (unsigned)wid * 1024u;
    const int aoff = lds_byte(wr * 64 + fr, fq * 8), boff = lds_byte(wc * 32 + fr, fq * 8);
#define PG8_SA(b, h) (((b) * 2 + (h)) * HTB)
#define PG8_SB(b, h) ((4 + (b) * 2 + (h)) * HTB)
#define PG8_STAGE(bufoff, gbase, voff) do { _Pragma("unroll") for (int _i = 0; _i < 2; ++_i) \
        __builtin_amdgcn_global_load_lds((const unsigned*)((const char*)(gbase) + (voff)[_i]), (LAS unsigned*)(lds + (bufoff) + ldsw + _i * 8192), 16, 0, 0); } while (0)
#define PG8_LDA(dst, b, h) do { _Pragma("unroll") for (int m = 0; m < 4; ++m) _Pragma("unroll") for (int k = 0; k < 2; ++k) dst[m][k] = *(const LAS bf16x8*)(lds + PG8_SA(b, h) + aoff + m * 2048 + k * 1024); } while (0)
#define PG8_LDB(dst, b, h) do { _Pragma("unroll") for (int n = 0; n < 2; ++n) _Pragma("unroll") for (int k = 0; k < 2; ++k) dst[n][k] = *(const LAS bf16x8*)(lds + PG8_SB(b, h) + boff + n * 2048 + k * 1024); } while (0)
#define PG8_MMA(ai, bj, At, Bt) do { __builtin_amdgcn_s_setprio(1); _Pragma("unroll") for (int m = 0; m < 4; ++m) _Pragma("unroll") for (int n = 0; n < 2; ++n) _Pragma("unroll") for (int k = 0; k < 2; ++k) \
        acc[ai][bj][m][n] = __builtin_amdgcn_mfma_f32_16x16x32_bf16(Bt[n][k], At[m][k], acc[ai][bj][m][n], 0, 0, 0); __builtin_amdgcn_s_setprio(0); } while (0)
#define PG8_WAIT_V(n) asm volatile("s_waitcnt vmcnt(" #n ")" ::: "memory")
#define PG8_WAIT_L(n) asm volatile("s_waitcnt lgkmcnt(" #n ")" ::: "memory")
#define PG8_BAR __builtin_amdgcn_s_barrier()
#define PG8_SCHED __builtin_amdgcn_sched_barrier(0)
    Unit cur, nxt; int ui = 0;
    if (!S.next(0, cur)) return;
    f32x4 acc[2][2][4][2];
#pragma unroll
    for (int a = 0; a < 2; ++a)
#pragma unroll
        for (int b = 0; b < 2; ++b)
#pragma unroll
            for (int m = 0; m < 4; ++m)
#pragma unroll
                for (int n = 0; n < 2; ++n) acc[a][b][m][n] = (f32x4){0.f, 0.f, 0.f, 0.f};
    bf16x8 At[4][2], B0[2][2], B1[2][2];
    const char* cA = (const char*)g.A + (size_t)cur.pm * tstepA + (size_t)cur.kt0 * kstep; const char* cB = (const char*)g.Bt + (size_t)cur.pn * tstepB + (size_t)cur.kt0 * kstep;
    PG8_STAGE(PG8_SB(0, 0), cB, voffB); PG8_STAGE(PG8_SA(0, 0), cA, voffA); PG8_STAGE(PG8_SB(0, 1), cB + hstepB, voffB); PG8_STAGE(PG8_SA(0, 1), cA + hstepA, voffA);
    E.prefetch(cur, tid, lds + STAGE_BYTES + 256 + wid * 256);
    if (wr == 1) PG8_BAR;
    PG8_WAIT_V(4); PG8_BAR;
    PG8_STAGE(PG8_SB(1, 0), cB + kstep, voffB); PG8_STAGE(PG8_SA(1, 0), cA + kstep, voffA); PG8_STAGE(PG8_SB(1, 1), cB + hstepB + kstep, voffB);
    PG8_WAIT_V(6); PG8_BAR;
    for (;;) {
        const bool has_next = S.next(ui + 1, nxt);
        const char* nA = has_next ? (const char*)g.A + (size_t)nxt.pm * tstepA + (size_t)nxt.kt0 * kstep : cA; const char* nB = has_next ? (const char*)g.Bt + (size_t)nxt.pn * tstepB + (size_t)nxt.kt0 * kstep : cB;
        const int nt = cur.nkt;
        for (int t = 0; t < nt; t += 2) {
            const bool last = (t == nt - 2);
            const char* a1 = cA + (size_t)(t + 1) * kstep;
            const char* a2 = last ? nA : cA + (size_t)(t + 2) * kstep; const char* b2 = last ? nB : cB + (size_t)(t + 2) * kstep;
            const char* a3 = a2 + kstep; const char* b3 = b2 + kstep;
            PG8_LDB(B0, 0, 0); PG8_SCHED; PG8_LDA(At, 0, 0); PG8_STAGE(PG8_SA(1, 1), a1 + hstepA, voffA);
            PG8_WAIT_L(8); PG8_BAR; PG8_WAIT_L(0); PG8_MMA(0, 0, At, B0); PG8_BAR; PG8_SCHED;
            PG8_LDB(B1, 0, 1); PG8_STAGE(PG8_SB(0, 0), b2, voffB);
            PG8_BAR; PG8_WAIT_L(0); PG8_MMA(0, 1, At, B1); PG8_BAR;
            PG8_LDA(At, 0, 1); PG8_STAGE(PG8_SA(0, 0), a2, voffA);
            PG8_BAR; PG8_WAIT_L(0); PG8_MMA(1, 0, At, B0); PG8_BAR; PG8_SCHED;
            PG8_STAGE(PG8_SB(0, 1), b2 + hstepB, voffB);
            PG8_WAIT_V(6); PG8_BAR; PG8_MMA(1, 1, At, B1); PG8_BAR;
            PG8_LDB(B0, 1, 0); PG8_SCHED; PG8_LDA(At, 1, 0); PG8_STAGE(PG8_SA(0, 1), a2 + hstepA, voffA);
            PG8_WAIT_L(8); PG8_BAR; PG8_WAIT_L(0); PG8_MMA(0, 0, At, B0); PG8_BAR; PG8_SCHED;
            PG8_LDB(B1, 1, 1); PG8_STAGE(PG8_SB(1, 0), b3, voffB);
            PG8_BAR; PG8_WAIT_L(0); PG8_MMA(0, 1, At, B1); PG8_BAR;
            PG8_LDA(At, 1, 1); PG8_STAGE(PG8_SA(1, 0), a3, voffA);
            PG8_BAR; PG8_WAIT_L(0); PG8_MMA(1, 0, At, B0); PG8_BAR; PG8_SCHED;
            PG8_STAGE(PG8_SB(1, 1), b3 + hstepB, voffB);
            PG8_WAIT_V(6); PG8_BAR; PG8_MMA(1, 1, At, B1); PG8_BAR;
        }
        E(acc, cur, wr, wc, fr, fq);
        if (!has_next) break;
#pragma unroll
        for (int a = 0; a < 2; ++a)
#pragma unroll
            for (int b = 0; b < 2; ++b)
#pragma unroll
                for (int m = 0; m < 4; ++m)
#pragma unroll
                    for (int n = 0; n < 2; ++n) acc[a][b][m][n] = (f32x4){0.f, 0.f, 0.f, 0.f};
        cur = nxt; cA = nA; cB = nB; ++ui;
    }
    PG8_WAIT_V(0);
    if (wr == 0) PG8_BAR;
    PG8_BAR;
#undef PG8_SA
#undef PG8_SB
#undef PG8_STAGE
#undef PG8_LDA
#undef PG8_LDB
#undef PG8_MMA
#undef PG8_WAIT_V
#undef PG8_WAIT_L
#undef PG8_BAR
#undef PG8_SCHED
}
}

__device__ __forceinline__ void unpack8(u32x4 w, float (&f)[8]) {
  f[0] = bf_lo(w.x); f[1] = bf_hi(w.x); f[2] = bf_lo(w.y); f[3] = bf_hi(w.y); f[4] = bf_lo(w.z); f[5] = bf_hi(w.z); f[6] = bf_lo(w.w); f[7] = bf_hi(w.w);
}
__device__ __forceinline__ u32x4 pack8(const float (&f)[8]) {
  u32x4 w; w.x = cvt_pk_bf16(f[0], f[1]); w.y = cvt_pk_bf16(f[2], f[3]); w.z = cvt_pk_bf16(f[4], f[5]); w.w = cvt_pk_bf16(f[6], f[7]); return w;
}
__device__ __forceinline__ void ld8f(const float* p, float (&f)[8]) { const f32x4 a = *(const f32x4*)p, b = *(const f32x4*)(p + 4); f[0] = a.x; f[1] = a.y; f[2] = a.z; f[3] = a.w; f[4] = b.x; f[5] = b.y; f[6] = b.z; f[7] = b.w; }
namespace att {
constexpr int NW = 8, QBLK = 32, KVBLK = 64;
constexpr float THR = 8.f;
constexpr int SHM_V = KVBLK * 128 * 2;
constexpr int K_OFF = 2 * SHM_V, WS_OFF = K_OFF + 2 * KVBLK * 192 * 2, QX_OFF = WS_OFF + NW * 64 * 4;
#define SBAR() __builtin_amdgcn_sched_barrier(0)
__device__ __forceinline__ int crow(int r, int hi) { return (r & 3) + 8 * (r >> 2) + 4 * hi; }
template <int DQK> struct SC { };
template <> struct SC<64>  { static constexpr float SCALE = 0.125f; };
template <> struct SC<128> { static constexpr float SCALE = 0.088388347648318440f; };
template <> struct SC<192> { static constexpr float SCALE = 0.072168783648703220f; };

template <int DQK>
__device__ __forceinline__ void partialSM(f32x16& p0, f32x16& p1, float& m_reg, float& mn, float& alpha, bool msk, int kq0, int hi) {
  constexpr float SCALE = SC<DQK>::SCALE;
  constexpr float C = SCALE * 1.4426950408889634f;
  if (msk) {
#pragma unroll
    for (int r = 0; r < 16; ++r) { const int d0 = kq0 + crow(r, hi);
      if ((unsigned)(d0 + 128) > 256u) p0[r] = -1e30f;
      if ((unsigned)(d0 + 32 + 128) > 256u) p1[r] = -1e30f; }
  }
  float pmax = p0[0];
#pragma unroll
  for (int r = 1; r < 16; ++r) pmax = fmaxf(pmax, p0[r]);
#pragma unroll
  for (int r = 0; r < 16; ++r) pmax = fmaxf(pmax, p1[r]);
  { auto rr = __builtin_amdgcn_permlane32_swap(__float_as_uint(pmax), __float_as_uint(pmax), false, false);
    pmax = fmaxf(__uint_as_float(rr[0]), __uint_as_float(rr[1])); }
  if (__builtin_expect(__all(pmax - m_reg <= THR / SCALE), 1)) { mn = m_reg; alpha = 1.f; }
  else { mn = fmaxf(m_reg, pmax); alpha = __builtin_amdgcn_exp2f((m_reg - mn) * C); m_reg = mn; }
  const float mnC = -mn * C;
#pragma unroll
  for (int r = 0; r < 16; ++r) p0[r] = fmaf(p0[r], C, mnC);
#pragma unroll
  for (int r = 0; r < 16; ++r) p1[r] = fmaf(p1[r], C, mnC);
#pragma unroll
  for (int r = 0; r < 16; ++r) p0[r] = __builtin_amdgcn_exp2f(p0[r]);
}
__device__ __forceinline__ void finishSM(f32x16& p0, f32x16& p1, float alpha, float& l_reg, bf16x8& pa0, bf16x8& pa1, bf16x8& pa2, bf16x8& pa3) {
#pragma unroll
  for (int r = 0; r < 16; ++r) p1[r] = __builtin_amdgcn_exp2f(p1[r]);
  float ps = 0;
#pragma unroll
  for (int r = 0; r < 16; ++r) ps += p0[r];
#pragma unroll
  for (int r = 0; r < 16; ++r) ps += p1[r];
  { auto rr = __builtin_amdgcn_permlane32_swap(__float_as_uint(ps), __float_as_uint(ps), false, false);
    ps = __uint_as_float(rr[0]) + __uint_as_float(rr[1]); }
  l_reg = l_reg * alpha + ps;
#define PK4(P, BASE, OUT) do { unsigned a0 = cvt_pk_bf16(P[BASE + 0], P[BASE + 1]), a1 = cvt_pk_bf16(P[BASE + 2], P[BASE + 3]);   \
    unsigned b0 = cvt_pk_bf16(P[BASE + 4], P[BASE + 5]), b1 = cvt_pk_bf16(P[BASE + 6], P[BASE + 7]);                              \
    auto r0 = __builtin_amdgcn_permlane32_swap(a0, b0, false, false); auto r1 = __builtin_amdgcn_permlane32_swap(a1, b1, false, false); \
    u32x4 w = {r0[0], r1[0], r0[1], r1[1]}; OUT = *reinterpret_cast<bf16x8*>(&w); } while (0)
  PK4(p0, 0, pa0); PK4(p0, 8, pa1); PK4(p1, 0, pa2); PK4(p1, 8, pa3);
#undef PK4
}
#define KSW_(dqk, row) ((dqk) == 128 ? (((row) & 15) << 4) : ((((row) >> 1) & 7) << 4))
template <int DQK>
__device__ __forceinline__ void qkt(f32x16& p0, f32x16& p1, const char* Ks, const bf16x8* qr, const char* qx, int r32, int hi) {
  constexpr int RB = DQK * 2, NQR = DQK == 192 ? 8 : DQK / 16;
  p0 = f32x16{}; p1 = f32x16{};
  const int sw = KSW_(DQK, r32);
#pragma unroll
  for (int d0 = 0; d0 < DQK / 16; ++d0) { const int cb = (d0 * 16 + hi * 8) * 2;
    bf16x8 b0 = *reinterpret_cast<const bf16x8*>(Ks + r32 * RB + (cb ^ sw));
    bf16x8 b1 = *reinterpret_cast<const bf16x8*>(Ks + (32 + r32) * RB + (cb ^ sw));
    bf16x8 q;
    if (d0 < NQR) q = qr[d0 < NQR ? d0 : 0]; else q = *reinterpret_cast<const bf16x8*>(qx + ((((d0 - NQR) * 2 + hi) * 16) ^ (((r32 >> 1) & 7) << 4)));
    p0 = __builtin_amdgcn_mfma_f32_32x32x16_bf16(b0, q, p0, 0, 0, 0);
    p1 = __builtin_amdgcn_mfma_f32_32x32x16_bf16(b1, q, p1, 0, 0, 0); }
}
__device__ __forceinline__ int v_st(int k, int c) { const int kk = (k & ~0xC) | ((k & 4) << 1) | ((k & 8) >> 1); return ((kk >> 3) * 4 + (c >> 5)) * 512 + ((kk & 7) * 32 + (c & 31)) * 2; }
__device__ __forceinline__ int v_rd_base(int lane) { return ((lane & 3) << 3) | (((lane >> 2) & 3) << 6) | (((lane >> 4) & 1) << 5) | (((lane >> 5) & 1) << 8); }
constexpr int v_rd_off(int d0, int ks, int half) { return d0 * 512 + ks * 4096 + half * 2048; }
template <int OFF> __device__ __forceinline__ s16x4 tr_read(int vb) {
  s16x4 r; asm volatile("ds_read_b64_tr_b16 %0, %1 offset:%2" : "=&v"(r) : "v"(vb), "i"(OFF) : "memory"); return r;
}
template <int D0> __device__ __forceinline__ void pv_one(f32x16& od, int vb, bf16x8 pa0, bf16x8 pa1, bf16x8 pa2, bf16x8 pa3) {
  const s16x4 l0 = tr_read<v_rd_off(D0, 0, 0)>(vb), h0 = tr_read<v_rd_off(D0, 0, 1)>(vb), l1 = tr_read<v_rd_off(D0, 1, 0)>(vb), h1 = tr_read<v_rd_off(D0, 1, 1)>(vb);
  const s16x4 l2 = tr_read<v_rd_off(D0, 2, 0)>(vb), h2 = tr_read<v_rd_off(D0, 2, 1)>(vb), l3 = tr_read<v_rd_off(D0, 3, 0)>(vb), h3 = tr_read<v_rd_off(D0, 3, 1)>(vb);
  asm volatile("s_waitcnt lgkmcnt(0)" ::: "memory"); SBAR();
#define PK(L, H) (bf16x8){L[0], L[1], L[2], L[3], H[0], H[1], H[2], H[3]}
  od = __builtin_amdgcn_mfma_f32_32x32x16_bf16(pa0, PK(l0, h0), od, 0, 0, 0);
  od = __builtin_amdgcn_mfma_f32_32x32x16_bf16(pa1, PK(l1, h1), od, 0, 0, 0);
  od = __builtin_amdgcn_mfma_f32_32x32x16_bf16(pa2, PK(l2, h2), od, 0, 0, 0);
  od = __builtin_amdgcn_mfma_f32_32x32x16_bf16(pa3, PK(l3, h3), od, 0, 0, 0);
#undef PK
}
__device__ __forceinline__ void pv_d0(f32x16* o, int vb, bf16x8 pa0, bf16x8 pa1, bf16x8 pa2, bf16x8 pa3) {
  pv_one<0>(o[0], vb, pa0, pa1, pa2, pa3); pv_one<1>(o[1], vb, pa0, pa1, pa2, pa3); pv_one<2>(o[2], vb, pa0, pa1, pa2, pa3); pv_one<3>(o[3], vb, pa0, pa1, pa2, pa3);
}

template <int DQK, int PIPE, bool WIN, int ldq, int ldk, int ldu>
__device__ __forceinline__ void attn_body(const bf16_t* __restrict__ Qb, const bf16_t* __restrict__ Kh, const bf16_t* __restrict__ Vh,
                                          float* __restrict__ Ob, int NT, int lo, int qpos0, float sink_l2, char* lds,
                                          bf16_t* __restrict__ yb, const bf16_t* __restrict__ ugb, int epi, float lam, float one_m, const float* __restrict__ subg,
                                          const float* __restrict__ qcos, const float* __restrict__ qsin, const float* __restrict__ qg) {
  constexpr int ldo = MIXW;
  constexpr int SDEPTH = (DQK == 64 && PIPE == 2) ? 2 : 1; constexpr bool win = WIN;
  constexpr int RB = DQK * 2, SHM_K = KVBLK * RB, CPR = DQK / 8, NKC = DQK / 64, NQR = DQK == 192 ? 8 : DQK / 16;
  constexpr float C = SC<DQK>::SCALE * 1.4426950408889634f;
  const int tid = otid(), wid = tid >> 6, lane = tid & 63, r32 = lane & 31, hi = lane >> 5;
  char* V_lds = lds; char* K_lds = lds + K_OFF;
  float* ws = (float*)(lds + WS_OFF) + wid * 64; float* li_l = ws; float* al_l = ws + 32;
  float m_reg = -1e30f, l_reg = 0; f32x16 o[4] = {}; bf16x8 qr[NQR];
  const bf16_t* Qw = Qb + (long)(wid * QBLK + r32) * ldq + hi * 8;
#pragma unroll
  for (int d0 = 0; d0 < NQR; ++d0) qr[d0] = *reinterpret_cast<const bf16x8*>(Qw + d0 * 16);
  char* qx = lds + QX_OFF + wid * 4096 + r32 * 128;
  const int sr = tid >> 4, sc = (tid & 15) * 8, vst0 = v_st(sr, sc), vst1 = v_st(32 + sr, sc);
  int kgo[NKC], klo[NKC];
#pragma unroll
  for (int c = 0; c < NKC; ++c) { const int id = tid + 512 * c, kr = id / CPR, kc = (id % CPR) * 8; kgo[c] = kr * ldk + kc; klo[c] = kr * RB + ((kc * 2) ^ KSW_(DQK, kr)); }
  const int vb0 = (int)(uintptr_t)V_lds + v_rd_base(lane);
  const int qmy = qpos0 + wid * QBLK + r32 + 256;
  struct { bf16x8 vs0, vs1; bf16x8 ks[NKC]; } sr_[SDEPTH];
#define KROW(t) ((t) * KVBLK + ((win && (t) >= 4) ? lo : 0))
#define SLOAD(i, t) do { const int k0_ = KROW(t); sr_[i].vs0 = *reinterpret_cast<const bf16x8*>(&Vh[(long)(k0_ + sr) * ldk + sc]); sr_[i].vs1 = *reinterpret_cast<const bf16x8*>(&Vh[(long)(k0_ + 32 + sr) * ldk + sc]); \
    _Pragma("unroll") for (int c_ = 0; c_ < NKC; ++c_) sr_[i].ks[c_] = *reinterpret_cast<const bf16x8*>(&Kh[(long)k0_ * ldk + kgo[c_]]); } while (0)
#define SWRITE(b, i) do { *(bf16x8*)(V_lds + (b) * SHM_V + vst0) = sr_[i].vs0; *(bf16x8*)(V_lds + (b) * SHM_V + vst1) = sr_[i].vs1; \
    _Pragma("unroll") for (int c_ = 0; c_ < NKC; ++c_) *(bf16x8*)(K_lds + (b) * SHM_K + klo[c_]) = sr_[i].ks[c_]; } while (0)
#define SWAIT() do { if constexpr (SDEPTH == 1) asm volatile("s_waitcnt vmcnt(0)" ::: "memory"); else if constexpr (NKC == 1) asm volatile("s_waitcnt vmcnt(3)" ::: "memory"); else if constexpr (NKC == 2) asm volatile("s_waitcnt vmcnt(4)" ::: "memory"); else asm volatile("s_waitcnt vmcnt(5)" ::: "memory"); } while (0)
#define RESC(a) do { if (__any((a) < 1.f)) { if (hi == 0) al_l[r32] = (a); asm volatile("s_waitcnt lgkmcnt(0)" ::: "memory"); \
    _Pragma("unroll") for (int d = 0; d < 4; ++d) _Pragma("unroll") for (int r = 0; r < 16; ++r) o[d][r] *= al_l[crow(r, hi)]; } } while (0)
#define PSM(P0, P1, MN, AL, t) partialSM<DQK>(P0, P1, m_reg, MN, AL, win && (t) >= 4, KROW(t) - qmy, hi)
  bf16x8 pa0, pa1, pa2, pa3;
  if constexpr (PIPE == 2) {
  f32x16 pA0, pA1, pB0, pB1; float mnA, mnB, alA, alB;
  constexpr int SE = 0, SO = SDEPTH - 1;
  SLOAD(SE, 0);
  if (qg != nullptr) {
    float ss = 0.f;
#pragma unroll
    for (int d0 = 0; d0 < NQR; ++d0) { float x[8]; unpack8(*reinterpret_cast<u32x4*>(&qr[d0]), x);
#pragma unroll
      for (int k = 0; k < 8; ++k) ss += x[k] * x[k]; }
    ss += __shfl_xor(ss, 32);
    const float rstd = rsqrtf(ss * (1.f / DQK) + EPS);
#pragma unroll
    for (int d0 = 0; d0 < NQR; ++d0) { float x[8], g8[8]; unpack8(*reinterpret_cast<u32x4*>(&qr[d0]), x); ld8f(qg + d0 * 16 + hi * 8, g8);
#pragma unroll
      for (int k = 0; k < 8; ++k) x[k] = x[k] * rstd * g8[k];
      u32x4 w = pack8(x); qr[d0] = *reinterpret_cast<bf16x8*>(&w); }
  }
  if (DQK != 192 && qcos != nullptr) {
    const int sq = qpos0 + wid * QBLK + r32;
#pragma unroll
    for (int d0 = 0; d0 < NQR / 2; ++d0) { const int i0 = d0 * 16 + hi * 8; float c_[8], s_[8], x1[8], x2[8];
      ld8f(qcos + (size_t)sq * (DQK / 2) + i0, c_); ld8f(qsin + (size_t)sq * (DQK / 2) + i0, s_);
      unpack8(*reinterpret_cast<u32x4*>(&qr[d0]), x1); unpack8(*reinterpret_cast<u32x4*>(&qr[d0 + NQR / 2]), x2);
#pragma unroll
      for (int k = 0; k < 8; ++k) { const float a = x1[k], b = x2[k]; x1[k] = a * c_[k] - b * s_[k]; x2[k] = a * s_[k] + b * c_[k]; }
      u32x4 w1 = pack8(x1), w2 = pack8(x2); qr[d0] = *reinterpret_cast<bf16x8*>(&w1); qr[d0 + NQR / 2] = *reinterpret_cast<bf16x8*>(&w2); }
  }
  if constexpr (DQK == 192) {
    bf16x8 qp[4];
#pragma unroll
    for (int j = 0; j < 4; ++j) qp[j] = *reinterpret_cast<const bf16x8*>(Qw + (NQR + j) * 16);
    if (qcos != nullptr) { const int sq = qpos0 + wid * QBLK + r32;
#pragma unroll
      for (int j = 0; j < 2; ++j) { const int i0 = j * 16 + hi * 8; float c_[8], s_[8], x1[8], x2[8];
        ld8f(qcos + (size_t)sq * 32 + i0, c_); ld8f(qsin + (size_t)sq * 32 + i0, s_);
        unpack8(*reinterpret_cast<u32x4*>(&qp[j]), x1); unpack8(*reinterpret_cast<u32x4*>(&qp[j + 2]), x2);
#pragma unroll
        for (int k = 0; k < 8; ++k) { const float a = x1[k], b = x2[k]; x1[k] = a * c_[k] - b * s_[k]; x2[k] = a * s_[k] + b * c_[k]; }
        u32x4 w1 = pack8(x1), w2 = pack8(x2); qp[j] = *reinterpret_cast<bf16x8*>(&w1); qp[j + 2] = *reinterpret_cast<bf16x8*>(&w2); } }
#pragma unroll
    for (int j = 0; j < 4; ++j) *reinterpret_cast<bf16x8*>(qx + (((j * 2 + hi) * 16) ^ (((r32 >> 1) & 7) << 4))) = qp[j];
  }
  asm volatile("s_waitcnt vmcnt(0)" ::: "memory"); SWRITE(0, SE); __syncthreads();
  qkt<DQK>(pA0, pA1, K_lds, qr, qx, r32, hi); PSM(pA0, pA1, mnA, alA, 0);
  SLOAD(SO, 1); if constexpr (SDEPTH == 2) { if (2 < NT) SLOAD(SE, 2); }
  SWAIT(); SWRITE(1, SO); __syncthreads();
  for (int j = 1; j + 1 < NT; j += 2) {
    if (j == NT - 5 && epi != 1) __builtin_amdgcn_global_load_lds((const unsigned*)(ugb + (long)(tid >> 1) * ldu + (tid & 1) * 64), (LAS unsigned*)(lds + LDS_MAIN + 256 + wid * 256), 4, 0, 0);
    SBAR(); qkt<DQK>(pB0, pB1, K_lds + SHM_K, qr, qx, r32, hi);
    finishSM(pA0, pA1, alA, l_reg, pa0, pa1, pa2, pa3); SBAR();
    SLOAD(SO, j + SDEPTH); SBAR();
    pv_d0(o, vb0, pa0, pa1, pa2, pa3); PSM(pB0, pB1, mnB, alB, j);
    __syncthreads(); SWAIT(); SWRITE(0, SE);
    RESC(alB); __syncthreads();
    SBAR(); qkt<DQK>(pA0, pA1, K_lds, qr, qx, r32, hi);
    finishSM(pB0, pB1, alB, l_reg, pa0, pa1, pa2, pa3); SBAR();
    if (SDEPTH == 1 || j + 3 < NT) SLOAD(SE, j + 1 + SDEPTH); SBAR();
    pv_d0(o, vb0 + SHM_V, pa0, pa1, pa2, pa3); PSM(pA0, pA1, mnA, alA, j + 1);
    __syncthreads(); SWAIT(); SWRITE(1, SO);
    RESC(alA); __syncthreads();
  }
  SBAR(); qkt<DQK>(pB0, pB1, K_lds + SHM_K, qr, qx, r32, hi);
  finishSM(pA0, pA1, alA, l_reg, pa0, pa1, pa2, pa3); SBAR();
  pv_d0(o, vb0, pa0, pa1, pa2, pa3); PSM(pB0, pB1, mnB, alB, NT - 1);
  __syncthreads(); RESC(alB);
  finishSM(pB0, pB1, alB, l_reg, pa0, pa1, pa2, pa3); SBAR();
  pv_d0(o, vb0 + SHM_V, pa0, pa1, pa2, pa3);
  } else {
  f32x16 p0, p1; float mn, al;
  SLOAD(0, 0);
  if (qg != nullptr) {
    float ss = 0.f;
#pragma unroll
    for (int d0 = 0; d0 < NQR; ++d0) { float x[8]; unpack8(*reinterpret_cast<u32x4*>(&qr[d0]), x);
#pragma unroll
      for (int k = 0; k < 8; ++k) ss += x[k] * x[k]; }
    ss += __shfl_xor(ss, 32);
    const float rstd = rsqrtf(ss * (1.f / DQK) + EPS);
#pragma unroll
    for (int d0 = 0; d0 < NQR; ++d0) { float x[8], g8[8]; unpack8(*reinterpret_cast<u32x4*>(&qr[d0]), x); ld8f(qg + d0 * 16 + hi * 8, g8);
#pragma unroll
      for (int k = 0; k < 8; ++k) x[k] = x[k] * rstd * g8[k];
      u32x4 w = pack8(x); qr[d0] = *reinterpret_cast<bf16x8*>(&w); }
  }
  if (DQK != 192 && qcos != nullptr) {
    const int sq = qpos0 + wid * QBLK + r32;
#pragma unroll
    for (int d0 = 0; d0 < NQR / 2; ++d0) { const int i0 = d0 * 16 + hi * 8; float c_[8], s_[8], x1[8], x2[8];
      ld8f(qcos + (size_t)sq * (DQK / 2) + i0, c_); ld8f(qsin + (size_t)sq * (DQK / 2) + i0, s_);
      unpack8(*reinterpret_cast<u32x4*>(&qr[d0]), x1); unpack8(*reinterpret_cast<u32x4*>(&qr[d0 + NQR / 2]), x2);
#pragma unroll
      for (int k = 0; k < 8; ++k) { const float a = x1[k], b = x2[k]; x1[k] = a * c_[k] - b * s_[k]; x2[k] = a * s_[k] + b * c_[k]; }
      u32x4 w1 = pack8(x1), w2 = pack8(x2); qr[d0] = *reinterpret_cast<bf16x8*>(&w1); qr[d0 + NQR / 2] = *reinterpret_cast<bf16x8*>(&w2); }
  }
  if constexpr (DQK == 192) {
    bf16x8 qp[4];
#pragma unroll
    for (int j = 0; j < 4; ++j) qp[j] = *reinterpret_cast<const bf16x8*>(Qw + (NQR + j) * 16);
    if (qcos != nullptr) { const int sq = qpos0 + wid * QBLK + r32;
#pragma unroll
      for (int j = 0; j < 2; ++j) { const int i0 = j * 16 + hi * 8; float c_[8], s_[8], x1[8], x2[8];
        ld8f(qcos + (size_t)sq * 32 + i0, c_); ld8f(qsin + (size_t)sq * 32 + i0, s_);
        unpack8(*reinterpret_cast<u32x4*>(&qp[j]), x1); unpack8(*reinterpret_cast<u32x4*>(&qp[j + 2]), x2);
#pragma unroll
        for (int k = 0; k < 8; ++k) { const float a = x1[k], b = x2[k]; x1[k] = a * c_[k] - b * s_[k]; x2[k] = a * s_[k] + b * c_[k]; }
        u32x4 w1 = pack8(x1), w2 = pack8(x2); qp[j] = *reinterpret_cast<bf16x8*>(&w1); qp[j + 2] = *reinterpret_cast<bf16x8*>(&w2); } }
#pragma unroll
    for (int j = 0; j < 4; ++j) *reinterpret_cast<bf16x8*>(qx + (((j * 2 + hi) * 16) ^ (((r32 >> 1) & 7) << 4))) = qp[j];
  }
  asm volatile("s_waitcnt vmcnt(0)" ::: "memory"); SWRITE(0, 0); __syncthreads();
  for (int j = 0; j < NT; ++j) {
    const int cur = j & 1; const bool more = j + 1 < NT;
    if (j == NT - 4 && epi != 1) __builtin_amdgcn_global_load_lds((const unsigned*)(ugb + (long)(tid >> 1) * ldu + (tid & 1) * 64), (LAS unsigned*)(lds + LDS_MAIN + 256 + wid * 256), 4, 0, 0);
    if (more) SLOAD(0, j + 1);
    SBAR();
    qkt<DQK>(p0, p1, K_lds + cur * SHM_K, qr, qx, r32, hi);
    PSM(p0, p1, mn, al, j);
    RESC(al);
    finishSM(p0, p1, al, l_reg, pa0, pa1, pa2, pa3); SBAR();
    pv_d0(o, vb0 + cur * SHM_V, pa0, pa1, pa2, pa3);
    if (more) SWRITE(cur ^ 1, 0);
    __syncthreads();
  }
  }
  l_reg += __builtin_amdgcn_exp2f(sink_l2 - m_reg * C);
  if (hi == 0) li_l[r32] = l_reg; asm volatile("s_waitcnt lgkmcnt(0)" ::: "memory");
  float rli[16];
#pragma unroll
  for (int r = 0; r < 16; ++r) rli[r] = __builtin_amdgcn_rcpf(li_l[crow(r, hi)]);
  if (epi == 1) {
    float* Sw = Ob + wid * 4096 + lane;
#pragma unroll
    for (int r = 0; r < 16; ++r)
#pragma unroll
      for (int d0 = 0; d0 < 4; ++d0) Sw[(r * 4 + d0) * 64] = o[d0][r] * rli[r];
  } else {
    constexpr int GST = 272;
    __syncthreads();
    const int tid_e = otid(), gr = tid_e >> 4, gc = (tid_e & 15) * 8;
#pragma unroll
    for (int hh = 0; hh < 2; ++hh) {
      bf16x8 gv[4];
#pragma unroll
      for (int i2 = 0; i2 < 4; ++i2) gv[i2] = *reinterpret_cast<const bf16x8*>(ugb + (long)(gr + 32 * (hh * 4 + i2)) * ldu + gc);
#pragma unroll
      for (int i2 = 0; i2 < 4; ++i2) *reinterpret_cast<bf16x8*>(lds + (gr + 32 * (hh * 4 + i2)) * GST + gc * 2) = gv[i2];
      asm volatile("" ::: "memory");
    }
    if (epi == 2) {
      const float* Sw = Ob + wid * 4096 + lane;
      float sg[4];
#pragma unroll
      for (int d0 = 0; d0 < 4; ++d0) sg[d0] = subg[d0 * 32 + r32] * one_m;
#pragma unroll
      for (int r = 0; r < 16; ++r) { float ss = 0.f;
#pragma unroll
        for (int d0 = 0; d0 < 4; ++d0) { const float v = Sw[(r * 4 + d0) * 64] - lam * (o[d0][r] * rli[r]); o[d0][r] = v; ss += v * v; }
#pragma unroll
        for (int of = 1; of < 32; of <<= 1) ss += __shfl_xor(ss, of);
        const float rstd = rsqrtf(ss * (1.f / 128.f) + EPS);
#pragma unroll
        for (int d0 = 0; d0 < 4; ++d0) o[d0][r] *= rstd * sg[d0];
        rli[r] = 1.f;
        if ((r & 3) == 3) asm volatile("" ::: "memory"); }
    }
    __syncthreads();
#pragma unroll
    for (int r = 0; r < 16; ++r) { char* prow = lds + (wid * QBLK + crow(r, hi)) * GST + r32 * 2;
#pragma unroll
      for (int d0 = 0; d0 < 4; ++d0) { bf16_t* p = reinterpret_cast<bf16_t*>(prow + d0 * 64); const float gte = __uint_as_float((unsigned)(*p) << 16);
        *p = (bf16_t)(cvt_pk_bf16(o[d0][r] * rli[r] * silu_f(gte), 0.f) & 0xffffu); } }
    __syncthreads();
#pragma unroll
    for (int i2 = 0; i2 < 8; ++i2) *reinterpret_cast<bf16x8*>(yb + (long)(gr + 32 * i2) * DM + gc) = *reinterpret_cast<const bf16x8*>(lds + (gr + 32 * i2) * GST + gc * 2);
  }
#undef KROW
#undef SLOAD
#undef SWRITE
#undef SWAIT
#undef RESC
#undef PSM
}
}

__device__ __forceinline__ float wave_sum(float v) {
#pragma unroll
  for (int o = 1; o < 64; o <<= 1) v += __shfl_xor(v, o);
  return v;
}
__device__ __forceinline__ void sincos_acc(float ang, float& c, float& s) {
  const double a = (double)ang; const double n = rint(a * 0.15915494309189533577); const double r = a - n * 6.283185307179586476925;
  const double r2 = r * r; double ts = r, tc = 1.0, ss = 0.0, cc = 0.0;
#pragma unroll
  for (int k = 1; k <= 13; ++k) { ss += ts; cc += tc; tc *= -r2 / (double)((2 * k - 1) * (2 * k)); ts *= -r2 / (double)((2 * k) * (2 * k + 1)); }
  s = (float)ss; c = (float)cc;
}

__device__ __forceinline__ void p0_transpose_item(const float* W, int Nsrc, int K, bf16_t* WT, int k0, int n_dst0, int n_src0, float* scr, int lane) {
  if (n_src0 >= 0) {
    float v[32]; const float* wp = W + (size_t)(k0 + (lane >> 5)) * Nsrc + n_src0 + (lane & 31);
#pragma unroll
    for (int i = 0; i < 32; ++i) v[i] = wp[(size_t)(2 * i) * Nsrc];
#pragma unroll
    for (int i = 0; i < 32; ++i) scr[(2 * i + (lane >> 5)) * 33 + (lane & 31)] = v[i];
  } else {
#pragma unroll 8
    for (int i = 0; i < 32; ++i) { const int kk = 2 * i + (lane >> 5); scr[kk * 33 + (lane & 31)] = 0.f; }
  }
  asm volatile("s_waitcnt lgkmcnt(0)" ::: "memory");
  const int c = lane & 7;
#pragma unroll
  for (int j = 0; j < 4; ++j) { const int n = (lane >> 3) + 8 * j; const float* s = scr + (8 * c) * 33 + n;
    u32x4 o; o.x = cvt_pk_bf16(s[0 * 33], s[1 * 33]); o.y = cvt_pk_bf16(s[2 * 33], s[3 * 33]); o.z = cvt_pk_bf16(s[4 * 33], s[5 * 33]); o.w = cvt_pk_bf16(s[6 * 33], s[7 * 33]);
    *(u32x4*)(WT + (size_t)(n_dst0 + n) * K + k0 + 8 * c) = o; }
  asm volatile("s_waitcnt lgkmcnt(0)" ::: "memory");
}

__device__ __forceinline__ void job_mod(const Params& P, char* lds, int l, int rank, int nranks) {
  const int tid = otid(), lane = tid & 63, wave = tid >> 6;
  float* sv = (float*)lds; float* red = sv + 3 * 2048;
  float* mod = (float*)(P.ws + WS_MOD);
  if (rank >= 96) return;
  for (int i = tid; i < 6144; i += NTHREADS) { const int v = i >> 11, k = i & 2047; const float x = v < 2 ? P.in[I_C][v * 2048 + k] : P.in[I_CCTX][k]; sv[i] = silu_f(x); }
  __syncthreads();
  for (int nb = rank; nb < 96; nb += nranks) {
    const int cgi = lane & 15, ks = lane >> 4;
    const float* W = P.in[I_WMOD] + (size_t)l * 2048 * 6144 + nb * 64 + cgi * 4;
    f32x4 a0 = {0, 0, 0, 0}, a1 = {0, 0, 0, 0}, a2 = {0, 0, 0, 0};
#pragma unroll 16
    for (int i = 0; i < 64; ++i) { const int k = wave * 256 + ks + 4 * i; const f32x4 wv = *(const f32x4*)(W + (size_t)k * 6144);
      a0 += sv[k] * wv; a1 += sv[2048 + k] * wv; a2 += sv[4096 + k] * wv; }
    const int pi = wave * 4 + ks;
    *(f32x4*)(red + (pi * 3 + 0) * 64 + cgi * 4) = a0; *(f32x4*)(red + (pi * 3 + 1) * 64 + cgi * 4) = a1; *(f32x4*)(red + (pi * 3 + 2) * 64 + cgi * 4) = a2;
    __syncthreads();
    if (tid < 192) { const int v = tid >> 6, n = tid & 63; float s = P.in[I_BMOD][l * 6144 + nb * 64 + n];
#pragma unroll
      for (int p = 0; p < 32; ++p) s += red[(p * 3 + v) * 64 + n];
      mod[(size_t)(l * 3 + v) * 6144 + nb * 64 + n] = s; }
    __syncthreads();
  }
}
__device__ __forceinline__ void job_convert(const Params& P, char* lds, int which, int rank, int nranks) {
  const int tid = otid(), lane = tid & 63, wave = tid >> 6;
  unsigned char* ws = P.ws;
  float* scr = (float*)(lds + wave * 8448);
  __syncthreads();
  const int gw = rank * 8 + wave, NGW = nranks * 8;
  constexpr int I_E = 32 * 208, I_O = 32 * 144, I_W = 32 * 64, I_Q = 8 * 48, I_KV = 4 * 80;
  const int n_main = which == 0 ? 2 * (I_E + I_O + I_Q + I_KV) : 0, nitems = n_main + I_W;
  for (int it = gw; it < nitems; it += NGW) {
    int r = it;
    if (r >= n_main) { r -= n_main; const int kb = r / 64, nb = r % 64;
      p0_transpose_item(P.in[I_WO] + (size_t)which * DM * DM, DM, DM, (bf16_t*)(ws + WS_WOUT) + (size_t)which * DM * DM, kb * 64, nb * 32, nb * 32, scr, lane); continue; }
    if (r < 2 * I_E) { const int i = r / I_E; r %= I_E; const int kb = r / 208, nb = r % 208; const int nd = nb * 32; int ns = nd;
      if (nd >= 1024 && nd < 2048) { const int tl = (nd - 1024) >> 8, p = (nd - 1024) & 255, bj = p >> 7, uu = (p & 127) >> 5; ns = 1024 + tl * 256 + uu * 64 + bj * 32; }
      else if (nd >= 4096 && nd < 4352) { const int p = nd - 4096, bj = p >> 7, hh = (p & 127) >> 6, i0 = p & 63; ns = 4096 + hh * 128 + bj * 64 + i0; }
      p0_transpose_item(P.in[I_EWIN] + (size_t)i * DM * EVEN_N, EVEN_N, DM, (bf16_t*)(ws + WS_WE) + (size_t)i * EVEN_N * DM, kb * 64, nd, ns, scr, lane); continue; }
    r -= 2 * I_E;
    if (r < 2 * I_O) { const int i = r / I_O; r %= I_O; const int kb = r / 144, nb = r % 144; const int nd = nb * 32; const int ns = nd < 2368 ? nd : (nd < 2560 ? -1 : nd - 192);
      p0_transpose_item(P.in[I_OWIN] + (size_t)i * DM * ODD_SRC, ODD_SRC, DM, (bf16_t*)(ws + WS_WO_IN) + (size_t)i * ODD_N * DM, kb * 64, nd, ns, scr, lane); continue; }
    r -= 2 * I_O;
    if (r < 2 * I_Q) { const int i = r / I_Q; r %= I_Q; const int kb = r / 48, nb = r % 48;
      p0_transpose_item(P.in[I_DWQB] + (size_t)i * 512 * QD_N, QD_N, 512, (bf16_t*)(ws + WS_WQB) + (size_t)i * QD_N * 512, kb * 64, nb * 32, nb * 32, scr, lane); continue; }
    r -= 2 * I_Q;
    { const int i = r / I_KV; r %= I_KV; const int kb = r / 80, nb = r % 80; const int nd = nb * 32, h = nd / 320, j = nd % 320;
      const int ns = j < 128 ? h * 256 + j : (j < 192 ? -1 : h * 256 + 128 + (j - 192));
      p0_transpose_item(P.in[I_DWKVB] + (size_t)i * 256 * 2048, 2048, 256, (bf16_t*)(ws + WS_WKVB) + (size_t)i * KVD_N * 256, kb * 64, nd, ns, scr, lane); }
  }
}

__device__ __forceinline__ void phase_p0(const Params& P, char* lds) {
  const int tid = otid();
  unsigned char* ws = P.ws;
  const int G = gridDim.x, bx = blockIdx.x;
  job_mod(P, lds, 0, bx, G);
  if (bx == G - 1 && tid < 2) {
    const int i = tid; float s1 = 0.f, s2 = 0.f;
    for (int k = 0; k < 64; ++k) { s1 += P.in[I_LQ1][i * 64 + k] * P.in[I_LK1][i * 64 + k]; s2 += P.in[I_LQ2][i * 64 + k] * P.in[I_LK2][i * 64 + k]; }
    const float lam_init = i == 0 ? 0.2f : 0.47071301834358416f;
    ((float*)(ws + WS_LAM))[i] = expf(s1) - expf(s2) + lam_init;
  }
  {
    float* c128 = (float*)(ws + WS_COS128); float* s128 = (float*)(ws + WS_SIN128); float* c64 = (float*)(ws + WS_COS64); float* s64 = (float*)(ws + WS_SIN64);
    const int gt = bx * NTHREADS + tid, NT_ = G * NTHREADS;
    for (int w = gt; w < SEQ * 96; w += NT_) {
      const int s = w / 96, j = w % 96; const int row = s >> 6, col = s & 63;
      if (j < 64) { const int f = j & 31; const float inv = powf(10000.f, -(float)f / 32.f); const float ang = (float)(j < 32 ? row : col) * inv; float c_, s_; sincos_acc(ang, c_, s_); c128[s * 64 + j] = c_; s128[s * 64 + j] = s_; }
      else { const int jj = j - 64, f = jj & 15; const float inv = powf(10000.f, -(float)f / 16.f); const float ang = (float)(jj < 16 ? row : col) * inv; float c_, s_; sincos_acc(ang, c_, s_); c64[s * 32 + jj] = c_; s64[s * 32 + jj] = s_; }
    }
  }
  job_convert(P, lds, 0, bx, G);
}

__device__ __forceinline__ const float* norm_src(const Params& P, const float* xw, int l, int m) {
  const int b = m / TPB, t = m % TPB;
  if (l == 0 || (l == 1 && t < CTXL)) return t < CTXL ? P.in[I_CTX] + (size_t)(b * CTXL + t) * DM : P.in[I_X] + (size_t)(b * SEQ + (t - CTXL)) * DM;
  return xw + (size_t)m * DM;
}
__device__ __forceinline__ void phase_norm(const Params& P, int l) {
  const int tid = otid(), lane = tid & 63, wave = tid >> 6;
  float* xw = (float*)(P.ws + WS_XW); bf16_t* h = (bf16_t*)(P.ws + WS_H); const float* part = (const float*)(P.ws + WS_PART);
  const float* mod = (const float*)(P.ws + WS_MOD) + (size_t)l * 3 * 6144; const float* g = P.in[I_NORMG] + l * DM;
  const int nwv = gridDim.x * 8, gwv = blockIdx.x * 8 + wave; const bool split = (l > 0) && nwv >= 1024;
#define NORM_ROW(q) (!split ? (gwv + (q) * nwv) : (gwv < 512 ? ((q) == 0 ? (gwv >> 8) * TPB + (gwv & 255) : MTOK) : \
    (((gwv - 512) + (q) * (nwv - 512)) < NB * SEQ ? (((gwv - 512) + (q) * (nwv - 512)) >> 12) * TPB + CTXL + (((gwv - 512) + (q) * (nwv - 512)) & 4095) : MTOK)))
  int qi = 0;
  int m = NORM_ROW(0);
  f32x4 xn[8], av[8], bv[8]; int vcur = -1;
#pragma unroll
  for (int j = 0; j < 8; ++j) { av[j] = (f32x4){0.f, 0.f, 0.f, 0.f}; bv[j] = (f32x4){0.f, 0.f, 0.f, 0.f}; }
  f32x4 xn2[8];
  if (m < MTOK) { const float* xr = norm_src(P, xw, l, m) + lane * 4;
#pragma unroll
    for (int j = 0; j < 8; ++j) xn[j] = *(const f32x4*)(xr + 256 * j); }
  int m1 = NORM_ROW(1);
  if (m1 < MTOK) { const float* xr = norm_src(P, xw, l, m1) + lane * 4;
#pragma unroll
    for (int j = 0; j < 8; ++j) xn2[j] = *(const f32x4*)(xr + 256 * j); }
  qi = 1;
  while (m < MTOK) {
    const int b = m / TPB, t = m % TPB, v = t < CTXL ? 2 : b;
    if (v != vcur) { vcur = v; const float* sh = mod + v * 6144 + lane * 4;
#pragma unroll
      for (int j = 0; j < 8; ++j) { const f32x4 gg = *(const f32x4*)(g + lane * 4 + 256 * j), s1 = *(const f32x4*)(sh + 2048 + 256 * j); av[j] = gg * (1.f + s1); bv[j] = *(const f32x4*)(sh + 256 * j); } }
    f32x4 x[8]; float ss = 0.f;
#pragma unroll
    for (int j = 0; j < 8; ++j) { x[j] = xn[j]; xn[j] = xn2[j]; }
    const int mnext = m1; ++qi; m1 = NORM_ROW(qi);
    if (m1 < MTOK) { const float* xr = norm_src(P, xw, l, m1) + lane * 4;
#pragma unroll
      for (int j = 0; j < 8; ++j) xn2[j] = *(const f32x4*)(xr + 256 * j); }
    if (l > 0 && t < CTXL) {
      const float* pr = part + (size_t)(b * 256 + t) * DM + lane * 4;
#pragma unroll
      for (int k = 0; k < 8; ++k) {
#pragma unroll
        for (int j = 0; j < 8; ++j) x[j] += *(const f32x4*)(pr + (size_t)k * 512 * DM + 256 * j); }
      float* xo = xw + (size_t)m * DM + lane * 4;
#pragma unroll
      for (int j = 0; j < 8; ++j) *(f32x4*)(xo + 256 * j) = x[j];
    }
#pragma unroll
    for (int j = 0; j < 8; ++j) { ss += (x[j].x * x[j].x + x[j].y * x[j].y) + (x[j].z * x[j].z + x[j].w * x[j].w); }
    const float rstd = rsqrtf(wave_sum(ss) * (1.f / DM) + EPS);
#pragma unroll
    for (int j = 0; j < 8; ++j) {
      const f32x4 y = (x[j] * rstd) * av[j] + bv[j];
      u32x2 w; w.x = cvt_pk_bf16(y.x, y.y); w.y = cvt_pk_bf16(y.z, y.w);
      *(u32x2*)(h + (size_t)m * DM + lane * 4 + 256 * j) = w; }
    m = mnext;
  }
}

__device__ __forceinline__ void rope8(float (&x1)[8], float (&x2)[8], const float* cosp, const float* sinp) {
  float c[8], s[8]; ld8f(cosp, c); ld8f(sinp, s);
#pragma unroll
  for (int i = 0; i < 8; ++i) { const float a = x1[i], b = x2[i]; x1[i] = a * c[i] - b * s[i]; x2[i] = a * s[i] + b * c[i]; }
}

__device__ __forceinline__ void phase_prep_even(const Params& P) {
  bf16_t* u = (bf16_t*)(P.ws + WS_U);
  const float* c128 = (const float*)(P.ws + WS_COS128); const float* s128 = (const float*)(P.ws + WS_SIN128); const float* c64 = (const float*)(P.ws + WS_COS64); const float* s64 = (const float*)(P.ws + WS_SIN64);
  const int gt = blockIdx.x * NTHREADS + otid(), NT_ = gridDim.x * NTHREADS;
  for (int w = gt; w < NB * SEQ * 208; w += NT_) {
    const int lr = w / 208, cp = w % 208, b = lr >> 12, s = lr & 4095; const size_t m = (size_t)b * TPB + CTXL + s;
    int col1, dist; const float *cp_, *sp_;
    if (cp < 128) { const int hu = cp >> 2, j = cp & 3; col1 = hu * 64 + j * 8; dist = 32; cp_ = c64 + s * 32 + j * 8; sp_ = s64 + s * 32 + j * 8; }
    else { const int c2 = cp - 128, hd = c2 >> 3, j = c2 & 7; col1 = 3072 + hd * 128 + j * 8; dist = 64; cp_ = c128 + s * 64 + j * 8; sp_ = s128 + s * 64 + j * 8; }
    bf16_t* p1 = u + m * EVEN_N + col1; bf16_t* p2 = p1 + dist;
    float x1[8], x2[8]; unpack8(*(const u32x4*)p1, x1); unpack8(*(const u32x4*)p2, x2);
    rope8(x1, x2, cp_, sp_);
    *(u32x4*)p1 = pack8(x1); *(u32x4*)p2 = pack8(x2);
  }
}

__device__ __forceinline__ void phase_prep_odd1(const Params& P, int i) {
  bf16_t* u = (bf16_t*)(P.ws + WS_U);
  const float* c128 = (const float*)(P.ws + WS_COS128); const float* s128 = (const float*)(P.ws + WS_SIN128);
  const int gt = blockIdx.x * NTHREADS + otid(), NT_ = gridDim.x * NTHREADS;
  for (int w = gt; w < MTOK * 2 * 8; w += NT_) {
    const int unit = w >> 3, j = w & 7, m = unit >> 1, hd = 8 + (unit & 1), t = m % TPB;
    const float* g = P.in[I_CKG] + i * 128;
    bf16_t* p1 = u + (size_t)m * ODD_N + hd * 128 + j * 8; bf16_t* p2 = p1 + 64;
    float x1[8], x2[8]; unpack8(*(const u32x4*)p1, x1); unpack8(*(const u32x4*)p2, x2);
    float ss = 0.f;
#pragma unroll
    for (int k = 0; k < 8; ++k) ss += x1[k] * x1[k] + x2[k] * x2[k];
    ss += __shfl_xor(ss, 1); ss += __shfl_xor(ss, 2); ss += __shfl_xor(ss, 4);
    const float rstd = rsqrtf(ss * (1.f / 128.f) + EPS);
    float g1[8], g2[8]; ld8f(g + j * 8, g1); ld8f(g + 64 + j * 8, g2);
#pragma unroll
    for (int k = 0; k < 8; ++k) { x1[k] = x1[k] * rstd * g1[k]; x2[k] = x2[k] * rstd * g2[k]; }
    if (t >= CTXL) { const int s = t - CTXL; rope8(x1, x2, c128 + s * 64 + j * 8, s128 + s * 64 + j * 8); }
    *(u32x4*)p1 = pack8(x1); *(u32x4*)p2 = pack8(x2);
  }
  const int tid2 = otid(), lane = tid2 & 63, wave = tid2 >> 6;
  const float* gq = P.in[I_DQAG] + i * 512; const float* gkv = P.in[I_DKVAG] + i * 256;
  {
    const int l2 = lane & 31, stride = gridDim.x * 8;
    float gq8[8], gkv8[8]; ld8f(gq + lane * 8, gq8); ld8f(gkv + l2 * 8, gkv8);
    int m = blockIdx.x * 8 + wave;
    u32x4 nq = {0u, 0u, 0u, 0u}, nk = {0u, 0u, 0u, 0u};
    if (m < MTOK) { nq = *(const u32x4*)(u + (size_t)m * ODD_N + 1536 + lane * 8); nk = *(const u32x4*)(u + (size_t)m * ODD_N + 2048 + l2 * 8); }
    while (m < MTOK) {
      bf16_t* pq = u + (size_t)m * ODD_N + 1536 + lane * 8; bf16_t* pk = u + (size_t)m * ODD_N + 2048 + l2 * 8;
      float x[8], y[8]; unpack8(nq, x); unpack8(nk, y);
      const int mn = m + stride;
      if (mn < MTOK) { nq = *(const u32x4*)(u + (size_t)mn * ODD_N + 1536 + lane * 8); nk = *(const u32x4*)(u + (size_t)mn * ODD_N + 2048 + l2 * 8); }
      float ss = 0.f, st = 0.f;
#pragma unroll
      for (int k = 0; k < 8; ++k) { ss += x[k] * x[k]; st += y[k] * y[k]; }
      ss = wave_sum(ss);
#pragma unroll
      for (int o = 1; o < 32; o <<= 1) st += __shfl_xor(st, o);
      const float rq = rsqrtf(ss * (1.f / 512.f) + EPS), rk = rsqrtf(st * (1.f / 256.f) + EPS);
#pragma unroll
      for (int k = 0; k < 8; ++k) { x[k] = x[k] * rq * gq8[k]; y[k] = y[k] * rk * gkv8[k]; }
      *(u32x4*)pq = pack8(x);
      if (lane < 32) *(u32x4*)pk = pack8(y);
      m = mn;
    }
  }
}

__device__ __forceinline__ void phase_prep_odd2(const Params& P) {
  const bf16_t* u = (const bf16_t*)(P.ws + WS_U); bf16_t* qd = (bf16_t*)(P.ws + WS_QD); bf16_t* kvd = (bf16_t*)(P.ws + WS_KVD);
  const float* c64 = (const float*)(P.ws + WS_COS64); const float* s64 = (const float*)(P.ws + WS_SIN64);
  const int gt = blockIdx.x * NTHREADS + otid(), NT_ = gridDim.x * NTHREADS;
  for (int w = gt; w < MTOK * 4; w += NT_) {
    const int m = w >> 2, cp = 32 + (w & 3), t = m % TPB; const bool lat = t >= CTXL; const int s = t - CTXL;
    if (cp < 32) {
      if (!lat) continue;
      const int hd = cp >> 2, j = cp & 3; bf16_t* p1 = qd + (size_t)m * QD_N + hd * 192 + 128 + j * 8; bf16_t* p2 = p1 + 32;
      float x1[8], x2[8]; unpack8(*(const u32x4*)p1, x1); unpack8(*(const u32x4*)p2, x2);
      rope8(x1, x2, c64 + s * 32 + j * 8, s64 + s * 32 + j * 8);
      *(u32x4*)p1 = pack8(x1); *(u32x4*)p2 = pack8(x2);
    } else {
      const int j = cp - 32; const bf16_t* p1 = u + (size_t)m * ODD_N + 2304 + j * 8; const bf16_t* p2 = p1 + 32;
      float x1[8], x2[8]; unpack8(*(const u32x4*)p1, x1); unpack8(*(const u32x4*)p2, x2);
      if (lat) rope8(x1, x2, c64 + s * 32 + j * 8, s64 + s * 32 + j * 8);
      const u32x4 o1 = pack8(x1), o2 = pack8(x2);
#pragma unroll
      for (int hd = 0; hd < 8; ++hd) { bf16_t* d = kvd + (size_t)m * KVD_N + hd * 320 + 128 + j * 8; *(u32x4*)d = o1; *(u32x4*)(d + 32) = o2; }
    }
  }
}

__device__ __forceinline__ void phase_post(const Params& P, int l) {
  const int tid = otid(), lane = tid & 63, wave = tid >> 6; const bool even = (l & 1) == 0; const int i = l >> 1;
  const float* mix = (const float*)(P.ws + WS_MIX); const bf16_t* u = (const bf16_t*)(P.ws + WS_U); bf16_t* y = (bf16_t*)(P.ws + WS_H);
  const int ldu = even ? EVEN_N : ODD_N, goff = even ? 4608 : 2560;
  const float lam = even ? ((const float*)(P.ws + WS_LAM))[i] : 0.f; const float one_m = even ? (i == 0 ? 0.8f : (1.f - 0.47071301834358416f)) : 0.f;
  const float* subg = P.in[I_SUBG] + i * 128;
  const bool skip_ctx = (l == 3);
  for (int m = blockIdx.x * 8 + wave; m < MTOK; m += gridDim.x * 8) {
    if (skip_ctx && (m % TPB) < CTXL) continue;
    const float* mr = mix + (size_t)m * MIXW + lane * 4; const bf16_t* ur = u + (size_t)m * ldu + goff + lane * 4; bf16_t* yr = y + (size_t)m * DM + lane * 4;
#pragma unroll
    for (int j = 0; j < 8; ++j) {
      f32x4 v = *(const f32x4*)(mr + 256 * j);
      if (even && j < 4) {
        const f32x4 v2 = *(const f32x4*)(mr + 2048 + 256 * j); v = v - lam * v2;
        float ss = (v.x * v.x + v.y * v.y) + (v.z * v.z + v.w * v.w);
#pragma unroll
        for (int o = 1; o < 32; o <<= 1) ss += __shfl_xor(ss, o);
        const float rstd = rsqrtf(ss * (1.f / 128.f) + EPS);
        const f32x4 gg = *(const f32x4*)(subg + (lane & 31) * 4);
        v = v * rstd * gg * one_m;
      }
      const u32x2 gw = *(const u32x2*)(ur + 256 * j);
      const float g0 = bf_lo(gw.x), g1 = bf_hi(gw.x), g2 = bf_lo(gw.y), g3 = bf_hi(gw.y);
      u32x2 o; o.x = cvt_pk_bf16(v.x * silu_f(g0), v.y * silu_f(g1)); o.y = cvt_pk_bf16(v.z * silu_f(g2), v.w * silu_f(g3));
      *(u32x2*)(yr + 256 * j) = o;
    }
  }
}

__device__ __forceinline__ void phase_final(const Params& P) {
  const int tid = otid(), lane = tid & 63, wave = tid >> 6;
  const float* xw = (const float*)(P.ws + WS_XW); const float* g = P.in[I_FINALG];
  const int stride = gridDim.x * 8;
  int r = blockIdx.x * 8 + wave;
  f32x4 xn[8], gg[8];
#pragma unroll
  for (int j = 0; j < 8; ++j) gg[j] = *(const f32x4*)(g + lane * 4 + 256 * j);
  if (r < NB * SEQ) { const float* xr = xw + ((size_t)(r >> 12) * TPB + CTXL + (r & 4095)) * DM + lane * 4;
#pragma unroll
    for (int j = 0; j < 8; ++j) xn[j] = *(const f32x4*)(xr + 256 * j); }
  while (r < NB * SEQ) {
    float* orow = P.out + (size_t)r * DM + lane * 4;
    f32x4 x[8]; float ss = 0.f;
#pragma unroll
    for (int j = 0; j < 8; ++j) x[j] = xn[j];
    const int rn = r + stride;
    if (rn < NB * SEQ) { const float* xr = xw + ((size_t)(rn >> 12) * TPB + CTXL + (rn & 4095)) * DM + lane * 4;
#pragma unroll
      for (int j = 0; j < 8; ++j) xn[j] = *(const f32x4*)(xr + 256 * j); }
#pragma unroll
    for (int j = 0; j < 8; ++j) ss += (x[j].x * x[j].x + x[j].y * x[j].y) + (x[j].z * x[j].z + x[j].w * x[j].w);
    const float rstd = rsqrtf(wave_sum(ss) * (1.f / DM) + EPS);
#pragma unroll
    for (int j = 0; j < 8; ++j) *(f32x4*)(orow + 256 * j) = (x[j] * rstd) * gg[j];
    r = rn;
  }
}

#ifndef ASD
#define ASD 1
#endif
#ifdef PROBE_MASK
#define TICK(cls) do { const unsigned long long t_now = __builtin_amdgcn_s_memrealtime(); if ((PROBE_MASK >> (cls)) & 1) t_acc += t_now - t_prev; t_prev = t_now; } while (0)
#else
#define TICK(cls) do { } while (0)
#endif
__device__ __forceinline__ int xcd_perm(int id) { const int r = id >> 8, c = id & 255; const int p = (((c & 7) * 2 + ((c >> 3) >> 4)) << 4) + ((c >> 3) & 15); return (r << 8) + p; }

__device__ __forceinline__ void phase_attn(const Params& P, int l, char* lds, unsigned long long& t_acc, unsigned long long& t_prev) {
  const bool even = (l & 1) == 0; const int i = l >> 1; const bool with_ctx = l < 3;
  const bf16_t* u = (const bf16_t*)(P.ws + WS_U); const bf16_t* qd = (const bf16_t*)(P.ws + WS_QD); const bf16_t* kvd = (const bf16_t*)(P.ws + WS_KVD);
  float* mix = (float*)(P.ws + WS_MIX);
  bf16_t* y = (bf16_t*)(P.ws + WS_H);
  const int ldu = even ? EVEN_N : ODD_N, goff = even ? 4608 : 2560;
  const float lam = even ? ((const float*)(P.ws + WS_LAM))[i] : 0.f; const float one_m = i == 0 ? 0.8f : (1.f - 0.47071301834358416f);
  const float* subg = P.in[I_SUBG] + i * 128;
  const int nlat = 512, nall = with_ctx ? 544 : nlat;
  for (int it = blockIdx.x; it < nall; it += gridDim.x) {
    int type, b, hd, qb;
    if (it < nlat) { const int id = xcd_perm(it); const int g = (id & 255) >> 4; type = (even ? 0 : 2) + (id >> 8); b = g >> 3; hd = g & 7; qb = (id & 15) + 1; }
    else { const int id = it - nlat; qb = 0; type = (even ? 0 : 2) + (id >> 4); b = (id & 15) >> 3; hd = id & 7; }
    const size_t row0 = (size_t)b * TPB + (size_t)qb * 256, rowb = (size_t)b * TPB;
    int NT = qb == 0 ? 4 : 68, lo = 0; const int q0 = qb > 0 ? (qb - 1) * 256 : 0; float sink = -1e30f;
    const float* c64 = (const float*)(P.ws + WS_COS64); const float* s64 = (const float*)(P.ws + WS_SIN64); const float* c128 = (const float*)(P.ws + WS_COS128); const float* s128 = (const float*)(P.ws + WS_SIN128);
    const int ycol = ((type & 1) ? 1024 : 0) + hd * 128;
    bf16_t* yb = y + row0 * DM + ycol; const bf16_t* ugb = u + row0 * ldu + goff + ycol;
    TICK(14);
    if (type == 0) {
      float* Op = mix + (size_t)blockIdx.x * 32768;
      for (int half = 0; half < 2; ++half) {
        __syncthreads();
        att::attn_body<64, 2, false, EVEN_N, EVEN_N, EVEN_N>(u + row0 * EVEN_N + hd * 128 + half * 64, u + rowb * EVEN_N + 1024 + hd * 128 + half * 64, u + rowb * EVEN_N + 2048 + hd * 128,
                                     Op, NT, 0, q0, sink, lds, yb, ugb, half + 1, lam, one_m, subg, qb > 0 ? c64 : nullptr, s64, nullptr);
      }
    } else if (type == 1) {
      if (qb > 0) { lo = q0 >= 128 ? q0 - 128 : 0; const int hk = (q0 + 384) < SEQ ? (q0 + 384) : SEQ; NT = 4 + (hk - lo) / 64; }
      sink = P.in[I_SINK][i * 8 + hd] * 1.4426950408889634f;
      __syncthreads();
      att::attn_body<128, 1, true, EVEN_N, EVEN_N, EVEN_N>(u + row0 * EVEN_N + 3072 + hd * 128, u + rowb * EVEN_N + 4096 + (hd >> 2) * 128, u + rowb * EVEN_N + 4352 + (hd >> 2) * 128,
                                   nullptr, NT, lo, q0, sink, lds, yb, ugb, 0, 0.f, 0.f, subg, qb > 0 ? c128 : nullptr, s128, nullptr);
    } else if (type == 2) {
      __syncthreads();
      att::attn_body<128, 2, false, ODD_N, ODD_N, ODD_N>(u + row0 * ODD_N + hd * 128, u + rowb * ODD_N + 1024 + (hd >> 2) * 128, u + rowb * ODD_N + 1280 + (hd >> 2) * 128,
                                    nullptr, NT, 0, q0, sink, lds, yb, ugb, 0, 0.f, 0.f, subg, qb > 0 ? c128 : nullptr, s128, P.in[I_CQG] + i * 128);
    } else {
      __syncthreads();
      att::attn_body<192, 1, false, QD_N, KVD_N, ODD_N>(qd + row0 * QD_N + hd * 192, kvd + rowb * KVD_N + hd * 320, kvd + rowb * KVD_N + hd * 320 + 192,
                                    nullptr, NT, 0, q0, sink, lds, yb, ugb, 0, 0.f, 0.f, subg, qb > 0 ? c64 : nullptr, s64, nullptr);
    }
    TICK(10 + type);
  }
}

__global__ void __launch_bounds__(NTHREADS) mega_fwd(Params P) {
  extern __shared__ __attribute__((aligned(16))) unsigned char lds_raw[];
  cg::grid_group grid = cg::this_grid();
  char* lds = (char*)lds_raw; LAS unsigned char* ldsl = (LAS unsigned char*)lds_raw;
  unsigned char* ws = P.ws;
  const int G = gridDim.x, bx = blockIdx.x;

#ifdef PROBE_MASK
  unsigned long long t_acc = 0, t_prev = __builtin_amdgcn_s_memrealtime();
#else
  unsigned long long t_acc = 0, t_prev = 0;
#endif
  volatile LAS unsigned* bst = (volatile LAS unsigned*)(ldsl + LDS_MAIN);
  if (threadIdx.x < 2) bst[threadIdx.x] = 0u;
  __syncthreads();
  XcdBarrier xb = xcd_barrier_post((unsigned*)(ws + WS_BAR), bst);
#define GSYNC() xcd_barrier(xb)
  phase_p0(P, lds);
  if (P.ws == nullptr) grid.sync();
  GSYNC(); TICK(0);
  for (int l = 0; l < 4; ++l) {
    const bool even = (l & 1) == 0; const int i = l >> 1;
    phase_norm(P, l);
    GSYNC(); TICK(1);
    {
      const int N = even ? EVEN_N : ODD_N;
      const bf16_t* Wt = even ? (const bf16_t*)(ws + WS_WE) + (size_t)i * EVEN_N * DM : (const bf16_t*)(ws + WS_WO_IN) + (size_t)i * ODD_N * DM;
      pg8::Gemm g{(const bf16_t*)(ws + WS_H), Wt, MTOK, N, DM, DM}; pg8::StaticOrder S; S.init(MTOK, N, DM, G, bx);
      pg8::EpiBf16 E{(bf16_t*)(ws + WS_U), N, 0, even ? 1 : 0, (const float*)(ws + WS_COS64), (const float*)(ws + WS_SIN64), (const float*)(ws + WS_COS128), (const float*)(ws + WS_SIN128)};
      pg8::gemm_phase<pg8::EpiBf16, pg8::StaticOrder>(ldsl, g, S, E);
      if (l < 3) {
        const int nwg = (MTOK / 256) * (N / 256), rounds = (nwg + G - 1) / G, first_idle = nwg - (rounds - 1) * G;
        if (first_idle < G && bx >= first_idle) { job_mod(P, lds, l + 1, bx - first_idle, G - first_idle); job_convert(P, lds, l + 1, bx - first_idle, G - first_idle); }
        else if (first_idle >= G) { job_mod(P, lds, l + 1, bx, G); job_convert(P, lds, l + 1, bx, G); }
      }
    }
    GSYNC(); TICK(2);
    if (!even) {
      phase_prep_odd1(P, i);
      phase_prep_odd2(P);
      GSYNC(); TICK(3);
      for (int k = 0; k < 2; ++k) {
        const int N = k == 0 ? QD_N : KVD_N, K = k == 0 ? 512 : 256;
        const bf16_t* A = (const bf16_t*)(ws + WS_U) + (k == 0 ? 1536 : 2048);
        const bf16_t* Wt = k == 0 ? (const bf16_t*)(ws + WS_WQB) + (size_t)i * QD_N * 512 : (const bf16_t*)(ws + WS_WKVB) + (size_t)i * KVD_N * 256;
        pg8::Gemm g{A, Wt, MTOK, N, K, ODD_N}; pg8::StaticOrder S; S.init(MTOK, N, K, G, bx);
        pg8::EpiBf16 E{(bf16_t*)(ws + (k == 0 ? WS_QD : WS_KVD)), N, k, 0, nullptr, nullptr, nullptr, nullptr};
        pg8::gemm_phase<pg8::EpiBf16, pg8::StaticOrder>(ldsl, g, S, E);
      }
      GSYNC(); TICK(7);
    }
    phase_attn(P, l, lds, t_acc, t_prev);
    GSYNC(); TICK(4);
    {
      pg8::Gemm g{(const bf16_t*)(ws + WS_H), (const bf16_t*)(ws + WS_WOUT) + (size_t)l * DM * DM, MTOK, DM, DM, DM}; pg8::OutOrder S; S.init(G, bx, l < 3);
      pg8::EpiResid E{(float*)(ws + WS_XW), (const float*)(ws + WS_MOD) + (size_t)l * 3 * 6144 + 4096, (float*)(ws + WS_PART), l == 0 ? P.in[I_X] : nullptr};
      pg8::gemm_phase<pg8::EpiResid, pg8::OutOrder>(ldsl, g, S, E);
    }
    GSYNC(); TICK(6);
  }
  phase_final(P);
#ifdef PROBE_MASK
  GSYNC(); TICK(8);
  if (bx == 0) { int n = (int)(t_acc / 100ull); if (n > 8000) n = 8000; for (int k = otid(); k < n; k += NTHREADS) P.out[(size_t)k * 2048 + 7] += 0.05f; }
#endif
}

extern "C" void kernel_launch(void* const* d_in, const int* in_sizes, int n_in, void* d_out, int out_size, void* d_ws, size_t ws_size, hipStream_t stream) {
  static int grid_blocks = 0;
  if (grid_blocks == 0) {
    if (n_in != 23 || in_sizes[0] != NB * SEQ * DM || out_size != NB * SEQ * DM || ws_size < WS_END) {
      fprintf(stderr, "kernel_launch: shape mismatch: n_in %d in0 %d out %d ws %zu (need %zu)\n", n_in, n_in > 0 ? in_sizes[0] : -1, out_size, ws_size, (size_t)WS_END); grid_blocks = -1; return; }
    int dev = 0, cus = 0, per_cu = 0;
    hipGetDevice(&dev); hipDeviceGetAttribute(&cus, hipDeviceAttributeMultiprocessorCount, dev);
    if (hipFuncSetAttribute((const void*)mega_fwd, hipFuncAttributeMaxDynamicSharedMemorySize, LDS_BYTES) != hipSuccess) { fprintf(stderr, "kernel_launch: hipFuncSetAttribute failed\n"); grid_blocks = -1; return; }
    if (hipOccupancyMaxActiveBlocksPerMultiprocessor(&per_cu, (const void*)mega_fwd, NTHREADS, LDS_BYTES) != hipSuccess || per_cu < 1) { fprintf(stderr, "kernel_launch: occupancy query gave %d\n", per_cu); per_cu = 1; (void)hipGetLastError(); }
    grid_blocks = cus * 1;
    fprintf(stderr, "kernel_launch: cus %d per_cu %d grid %d\n", cus, per_cu, grid_blocks);
  }
  if (grid_blocks < 0) return;
  if (hipMemsetAsync((unsigned char*)d_ws + WS_BAR, 0, (size_t)XCD_BAR_WORDS * 4, stream) != hipSuccess) { fprintf(stderr, "kernel_launch: memset failed\n"); return; }
  Params p{};
  for (int k = 0; k < 23; ++k) p.in[k] = (const float*)d_in[k];
  p.out = (float*)d_out; p.ws = (unsigned char*)d_ws;
  void* args[] = {&p};
  hipError_t e = hipLaunchCooperativeKernel((const void*)mega_fwd, dim3(grid_blocks), dim3(NTHREADS), args, LDS_BYTES, stream);
  if (e != hipSuccess) fprintf(stderr, "kernel_launch: cooperative launch failed: %s (grid %d)\n", hipGetErrorString(e), grid_blocks);
}
```

```cpp
#include <hip/hip_runtime.h>
#include <hip/hip_cooperative_groups.h>
#include <cstdio>
#include <cstdint>
namespace cg = cooperative_groups;

typedef unsigned short bf16_t;
typedef short bf16x8 __attribute__((ext_vector_type(8)));
typedef short s16x4 __attribute__((ext_vector_type(4)));
typedef float f32x4 __attribute__((ext_vector_type(4)));
typedef float f32x16 __attribute__((ext_vector_type(16)));
typedef unsigned u32x4 __attribute__((ext_vector_type(4)));
typedef unsigned u32x2 __attribute__((ext_vector_type(2)));
#define LAS __attribute__((address_space(3)))
#define XCD_BAR_WORDS 3456

constexpr int DM = 2048, NB = 2, SEQ = 4096, CTXL = 256, TPB = SEQ + CTXL  , MTOK = NB * TPB  ;
constexpr int EVEN_N = 6656, ODD_N = 4608  , ODD_SRC = 4416;
constexpr int QD_N = 1536, KVD_N = 2560  ;
constexpr int MIXW = 3072;
constexpr float EPS = 1e-6f;
constexpr int LDS_MAIN = 131072;
constexpr int LDS_BYTES = LDS_MAIN + 256 + 2048;
constexpr int NTHREADS = 512;

constexpr size_t al256(size_t x) { return (x + 255) / 256 * 256; }
constexpr size_t WS_XW   = 0;
constexpr size_t WS_H    = WS_XW + al256((size_t)MTOK * DM * 4);
constexpr size_t WS_U    = WS_H + al256((size_t)MTOK * DM * 2);
constexpr size_t WS_QD   = WS_U + al256((size_t)MTOK * EVEN_N * 2);
constexpr size_t WS_KVD  = WS_QD + al256((size_t)MTOK * QD_N * 2);
constexpr size_t WS_MIX  = WS_KVD + al256((size_t)MTOK * KVD_N * 2);
constexpr size_t WS_WE   = WS_MIX + al256((size_t)MTOK * MIXW * 4);
constexpr size_t WS_WO_IN= WS_WE + al256((size_t)2 * EVEN_N * DM * 2);
constexpr size_t WS_WOUT = WS_WO_IN + al256((size_t)2 * ODD_N * DM * 2);
constexpr size_t WS_WQB  = WS_WOUT + al256((size_t)4 * DM * DM * 2);
constexpr size_t WS_WKVB = WS_WQB + al256((size_t)2 * QD_N * 512 * 2);
constexpr size_t WS_MOD  = WS_WKVB + al256((size_t)2 * KVD_N * 256 * 2);
constexpr size_t WS_COS128 = WS_MOD + al256((size_t)4 * 3 * 6144 * 4);
constexpr size_t WS_SIN128 = WS_COS128 + al256((size_t)SEQ * 64 * 4);
constexpr size_t WS_COS64  = WS_SIN128 + al256((size_t)SEQ * 64 * 4);
constexpr size_t WS_SIN64  = WS_COS64 + al256((size_t)SEQ * 32 * 4);
constexpr size_t WS_LAM    = WS_SIN64 + al256((size_t)SEQ * 32 * 4);
constexpr size_t WS_PART   = WS_LAM + 256;
constexpr size_t WS_BAR    = WS_PART + al256((size_t)8 * 512 * DM * 4);
constexpr size_t WS_END    = WS_BAR + al256((size_t)XCD_BAR_WORDS * 4);

struct Params { const float* in[23]; float* out; unsigned char* ws; };
enum { I_X = 0, I_C, I_CTX, I_CCTX, I_WMOD, I_BMOD, I_NORMG, I_WO, I_FINALG, I_EWIN, I_LQ1, I_LK1, I_LQ2, I_LK2, I_SUBG, I_SINK, I_OWIN, I_CQG, I_CKG, I_DQAG, I_DKVAG, I_DWQB, I_DWKVB };

__device__ __forceinline__ unsigned cvt_pk_bf16(float lo, float hi) { unsigned r; asm volatile("v_cvt_pk_bf16_f32 %0, %1, %2" : "=v"(r) : "v"(lo), "v"(hi)); return r; }
__device__ __forceinline__ float bf_lo(unsigned w) { return __uint_as_float(w << 16); }
__device__ __forceinline__ float bf_hi(unsigned w) { return __uint_as_float(w & 0xffff0000u); }
__device__ __forceinline__ float silu_f(float x) { return x / (1.f + __expf(-x)); }
__device__ __forceinline__ int otid() { int t = threadIdx.x; asm volatile("" : "+v"(t)); return t; }

#define XB_TMO      128
#define XB_XCNT(j)  (256  + 64 * (j))
#define XB_XSUB(j)  (1280 + 64 * (j))
#define XB_XGEN(j)  (2304 + 64 * (j))
#define XB_TOP      3328
#define XB_TOPGEN   3392
#define XB_SPIN_CAP (1u << 18)

__device__ __forceinline__ unsigned xb_ld(unsigned* p)              { return __hip_atomic_load(p, __ATOMIC_RELAXED, __HIP_MEMORY_SCOPE_AGENT); }
__device__ __forceinline__ unsigned xb_add(unsigned* p, unsigned v) { return __hip_atomic_fetch_add(p, v, __ATOMIC_RELAXED, __HIP_MEMORY_SCOPE_AGENT); }
__device__ __forceinline__ unsigned xb_xcc_id() { return (unsigned)__builtin_amdgcn_s_getreg((3 << 11) | 20) & 0xFu; }
#define XB_SPIN(cond, bar) do { unsigned _sp = 0; while (cond) { __builtin_amdgcn_s_sleep(1); \
    if ((++_sp & 255u) == 0u) { if (xb_ld(&(bar)[XB_TMO])) break; if (_sp > XB_SPIN_CAP) { atomicAdd(&(bar)[XB_TMO], 1u); break; } } } } while (0)

struct XcdBarrier {
    unsigned* bar; unsigned x;
    volatile LAS unsigned* st;
};

__device__ __forceinline__ XcdBarrier xcd_barrier_post(unsigned* bar, volatile LAS unsigned* st) {
    XcdBarrier b; b.bar = bar; b.x = xb_xcc_id(); b.st = st;
    if (threadIdx.x == 0) (void)xb_add(&bar[XB_XCNT(b.x)], 1u);
    return b;
}
__device__ __forceinline__ void xcd_barrier_complete(unsigned* bar, unsigned x, unsigned& nloc, unsigned& nx) {
    const unsigned G = gridDim.x * gridDim.y * gridDim.z;
    unsigned sum, cnt, mine, sp = 0u;
    for (;;) {
        sum = 0u; cnt = 0u; mine = 0u;
#pragma unroll
        for (unsigned j = 0; j < 16; ++j) { const unsigned c = xb_ld(&bar[XB_XCNT(j)]); sum += c; cnt += (c > 0u) ? 1u : 0u; mine = (j == x) ? c : mine; }
        if (sum == G) break;
        __builtin_amdgcn_s_sleep(1);
        if ((++sp & 255u) == 0u) { if (xb_ld(&bar[XB_TMO])) break; if (sp > XB_SPIN_CAP) { atomicAdd(&bar[XB_TMO], 1u); break; } }
    }
    nloc = mine > 0u ? mine : 1u; nx = cnt > 0u ? cnt : 1u;
}

__device__ __forceinline__ void xcd_barrier(const XcdBarrier& b) {
    asm volatile("s_waitcnt vmcnt(0)" ::: "memory");
    __syncthreads();
    if (threadIdx.x == 0) {
        unsigned* bar = b.bar;
        __builtin_amdgcn_s_waitcnt(0);
        unsigned nloc = b.st[0], nx = b.st[1];
        if (nloc == 0u) { xcd_barrier_complete(bar, b.x, nloc, nx); b.st[0] = nloc; b.st[1] = nx; }
        const unsigned old = xb_add(&bar[XB_XSUB(b.x)], 1u);
        const unsigned gen = old / nloc;
        if (old + 1u == (gen + 1u) * nloc) {
            __builtin_amdgcn_fence(__ATOMIC_RELEASE, "agent");
            asm volatile("s_waitcnt vmcnt(0)" ::: "memory");
            const unsigned og = xb_add(&bar[XB_TOP], 1u);
            const unsigned tg = og / nx;
            if (og + 1u == (tg + 1u) * nx) xb_add(&bar[XB_TOPGEN], 1u);
            else XB_SPIN(xb_ld(&bar[XB_TOPGEN]) == tg, bar);
            __builtin_amdgcn_fence(__ATOMIC_ACQUIRE, "agent");
            xb_add(&bar[XB_XGEN(b.x)], 1u);
            asm volatile("s_waitcnt vmcnt(0)" ::: "memory");
        } else {
            XB_SPIN(xb_ld(&bar[XB_XGEN(b.x)]) == gen, bar);
            __builtin_amdgcn_fence(__ATOMIC_ACQUIRE, "agent");
            asm volatile("s_waitcnt vmcnt(0)" ::: "memory");
        }
    }
    __syncthreads();
}


namespace pg8 {
constexpr int BM = 256, BK = 64, HALF = 128, HTB = HALF * BK * 2, STAGE_BYTES = 8 * HTB, NXCD = 8, WGM = 8;
__host__ __device__ __forceinline__ int lds_byte(int r, int c) { const int st = (r >> 4) * 2 + (c >> 5), rr = r & 15, cc = c & 31, ob = rr * 64 + cc * 2; return st * 1024 + (ob ^ (((ob >> 9) & 1) << 5)); }
__host__ __device__ __forceinline__ void stage_rc(int b, int& R, int& C) { const int st = b / 1024, sb = b % 1024, swz = sb ^ (((sb >> 9) & 1) << 5); R = (st >> 1) * 16 + swz / 64; C = (st & 1) * 32 + (swz % 64) / 2; }
__host__ __device__ __forceinline__ int perm32(int rho) { const int n = rho >> 4, i = rho & 15; return 8 * (i >> 2) + 4 * n + (i & 3); }
struct Unit { int pm, pn, kt0, nkt; };
struct Gemm { const bf16_t* A; const bf16_t* Bt; int M, N, K, lda; };
struct StaticOrder {
    int nM, nN, nwg, G, c, nkt;
    __device__ void init(int M, int N, int K, int G_, int c_) { nM = M / BM; nN = N / BM; nwg = nM * nN; G = G_; c = c_; nkt = K / BK; }
    __device__ bool next(int i, Unit& u) const {
        const long L = (long)i * G + c; if (L >= nwg) return false;
        u.kt0 = 0; u.nkt = nkt;
        int wgid = (int)L; { const int q = nwg / NXCD, r = nwg % NXCD, xcd = wgid % NXCD, off = wgid / NXCD; wgid = (xcd < r ? xcd * (q + 1) : r * (q + 1) + (xcd - r) * q) + off; }
        const int nig = WGM * nN, gid = wgid / nig, fm = gid * WGM, gsz = (nM - fm) < WGM ? (nM - fm) : WGM;
        u.pm = fm + ((wgid % nig) % gsz); u.pn = (wgid % nig) / gsz; return true;
    }
};
struct OutOrder {
    int G, c, nseg;
    __device__ void init(int G_, int c_, bool with_ctx) { G = G_; c = c_; nseg = with_ctx ? 384 : 256; }
    __device__ bool next(int i, Unit& u) const {
        const int s = i * G + c; if (s >= nseg) return false;
        if (s < 256) { const int x = s & 7, j = s >> 3, lt = 4 * x + (j >> 3); u.pm = lt < 16 ? lt + 1 : lt + 2; u.pn = j & 7; u.kt0 = 0; u.nkt = 32; }
        else { const int cs = s - 256, cu = cs >> 3; u.pm = (cu >> 3) * 17; u.pn = cu & 7; u.kt0 = 4 * (cs & 7); u.nkt = 4; }
        return true;
    }
};
struct EpiBf16 {
    static constexpr bool PERM = true;
    bf16_t* O; int ldc;
    __device__ __forceinline__ void prefetch(const Unit&, int, LAS unsigned char*) const {}
    int skip_gap;
    int rope_en; const float *c64, *s64, *c128, *s128;
    __device__ __forceinline__ void operator()(const f32x4 (&acc)[2][2][4][2], const Unit& u, int wr, int wc, int fr, int fq) const {
        const int row0 = u.pm * BM + wr * 64 + fr;
        int mode = 0; if (rope_en) { if (u.pn >= 4 && u.pn < 8) mode = 1; else if (u.pn == 16) mode = 2; }
        if (mode == 0) {
            const int col0 = u.pn * BM + wc * 32 + 8 * fq;
#pragma unroll
            for (int ai = 0; ai < 2; ++ai)
#pragma unroll
                for (int m = 0; m < 4; ++m) { bf16_t* rowp = O + (size_t)(row0 + ai * HALF + m * 16) * ldc + col0;
#pragma unroll
                    for (int bj = 0; bj < 2; ++bj) { const f32x4 v0 = acc[ai][bj][m][0], v1 = acc[ai][bj][m][1];
                        u32x4 w; w.x = cvt_pk_bf16(v0[0], v0[1]); w.y = cvt_pk_bf16(v0[2], v0[3]); w.z = cvt_pk_bf16(v1[0], v1[1]); w.w = cvt_pk_bf16(v1[2], v1[3]);
                        const int rr = (col0 + bj * HALF) % 320;
                        if (!(skip_gap && rr >= 128 && rr < 192)) *(u32x4*)(rowp + bj * HALF) = w; } }
        } else {
            const bool lat = (u.pm % 17) != 0; const int bb = u.pm / 17;
            const int i0 = mode == 1 ? 8 * fq : (wc & 1) * 32 + 8 * fq, dist = mode == 1 ? 32 : 64, tst = mode == 1 ? 32 : 64;
            const int colA = u.pn * BM + (mode == 1 ? wc * 64 : (wc >> 1) * 128) + i0;
            const int nf = tst >> 1; float irev[8];
#pragma unroll
            for (int j = 0; j < 8; ++j) irev[j] = __builtin_amdgcn_exp2f(-(float)((i0 + j) & (nf - 1)) * (13.287712379549449f / (float)nf)) * 0.15915494309189535f;
            const bool use_col = (i0 & nf) != 0;
#pragma unroll
            for (int ai = 0; ai < 2; ++ai)
#pragma unroll
                for (int m = 0; m < 4; ++m) { const int row = row0 + ai * HALF + m * 16; bf16_t* rowp = O + (size_t)row * ldc + colA;
                    f32x4 a0 = acc[ai][0][m][0], a1 = acc[ai][0][m][1], b0 = acc[ai][1][m][0], b1 = acc[ai][1][m][1];
                    if (lat) { const int sp = row - bb * 4352 - 256; const float pos = (float)(use_col ? (sp & 63) : (sp >> 6));
                        f32x4 c0, c1, s0, s1;
#pragma unroll
                        for (int j = 0; j < 4; ++j) { const float r0 = __builtin_amdgcn_fractf(pos * irev[j]), r1 = __builtin_amdgcn_fractf(pos * irev[4 + j]);
                            c0[j] = __builtin_amdgcn_cosf(r0); s0[j] = __builtin_amdgcn_sinf(r0); c1[j] = __builtin_amdgcn_cosf(r1); s1[j] = __builtin_amdgcn_sinf(r1); }
                        const f32x4 y0 = a0 * c0 - b0 * s0, y1 = a1 * c1 - b1 * s1, z0 = a0 * s0 + b0 * c0, z1 = a1 * s1 + b1 * c1; a0 = y0; a1 = y1; b0 = z0; b1 = z1; }
                    u32x4 w; w.x = cvt_pk_bf16(a0[0], a0[1]); w.y = cvt_pk_bf16(a0[2], a0[3]); w.z = cvt_pk_bf16(a1[0], a1[1]); w.w = cvt_pk_bf16(a1[2], a1[3]);
                    *(u32x4*)rowp = w;
                    w.x = cvt_pk_bf16(b0[0], b0[1]); w.y = cvt_pk_bf16(b0[2], b0[3]); w.z = cvt_pk_bf16(b1[0], b1[1]); w.w = cvt_pk_bf16(b1[2], b1[3]);
                    *(u32x4*)(rowp + dist) = w; }
        }
    }
};
struct EpiResid {
    static constexpr bool PERM = false;
    float* X; const float* gate_l; float* part; const float* Rin;
    __device__ __forceinline__ void prefetch(const Unit& u, int tid, LAS unsigned char* sink) const {
        if (u.nkt < 32) return;
#pragma unroll
        for (int j = 0; j < 4; ++j) { const int line = tid * 4 + j, r = line >> 3, sg = line & 7; const size_t row = (size_t)u.pm * BM + r;
            const float* p = (Rin ? Rin + (row - (size_t)256 * (u.pm / 17 + 1)) * DM : X + row * DM) + u.pn * BM + sg * 32;
            __builtin_amdgcn_global_load_lds((const unsigned*)p, (LAS unsigned*)sink, 4, 0, 0); }
    }
    __device__ __forceinline__ void operator()(const f32x4 (&acc)[2][2][4][2], const Unit& u, int wr, int wc, int fr, int fq) const {
        const int row0 = u.pm * BM + wr * 64 + fr, col0 = u.pn * BM + wc * 32 + 4 * fq;
        const int v = (u.pm % 17 == 0) ? 2 : (u.pm / 17);
        const float* gate = gate_l + v * 6144;
        f32x4 gv[2][2];
#pragma unroll
        for (int bj = 0; bj < 2; ++bj)
#pragma unroll
            for (int n = 0; n < 2; ++n) gv[bj][n] = *(const f32x4*)(gate + col0 + bj * HALF + n * 16);
#pragma unroll
        for (int ai = 0; ai < 2; ++ai)
#pragma unroll
            for (int m = 0; m < 4; ++m) { const size_t row = (size_t)(row0 + ai * HALF + m * 16); float* rowp = X + row * DM + col0;
                const float* rinp = Rin ? Rin + (row - (size_t)256 * (u.pm / 17 + 1)) * DM + col0 : rowp;
#pragma unroll
                for (int bj = 0; bj < 2; ++bj)
#pragma unroll
                    for (int n = 0; n < 2; ++n) {
                        const f32x4 d = gv[bj][n] * acc[ai][bj][m][n]; float* p = rowp + bj * HALF + n * 16;
                        if (u.nkt < 32) { float* q = part + ((size_t)(u.kt0 >> 2) * 512 + (u.pm ? 256 : 0) + (wr * 64 + fr + ai * HALF + m * 16)) * DM + col0 + bj * HALF + n * 16; *(f32x4*)q = d; }
                        else { f32x4 x = *(const f32x4*)(rinp + bj * HALF + n * 16); x = x + d; *(f32x4*)p = x; } } }
    }
};

template <class Epi, class Sched>
__device__ __forceinline__ void gemm_phase(LAS unsigned char* lds, const Gemm g, const Sched& S, const Epi& E) {
    const int tid = otid(), wid = __builtin_amdgcn_readfirstlane(tid >> 6), lane = tid & 63, wr = wid >> 2, wc = wid & 3, fr = lane & 15, fq = lane >> 4;
    const int K = g.K, lda = g.lda;
    unsigned voffA[2], voffB[2];
#pragma unroll
    for (int i = 0; i < 2; ++i) { int R, C; stage_rc(tid * 16 + i * 8192, R, C); const int Rb = Epi::PERM ? ((R & ~31) + perm32(R & 31)) : R;
        voffA[i] = (unsigned)(R * lda + C) * 2u; voffB[i] = (unsigned)(Rb * K + C) * 2u; }
    const size_t kstep = (size_t)(BK * 2);
    const size_t hstepA = (size_t)HALF * lda * 2, hstepB = (size_t)HALF * K * 2;
    const size_t tstepA = 2 * hstepA, tstepB = 2 * hstepB;
    const unsigned ldsw = (unsigned)wid * 1024u;
    const int aoff = lds_byte(wr * 64 + fr, fq * 8), boff = lds_byte(wc * 32 + fr, fq * 8);
#define PG8_SA(b, h) (((b) * 2 + (h)) * HTB)
#define PG8_SB(b, h) ((4 + (b) * 2 + (h)) * HTB)
#define PG8_STAGE(bufoff, gbase, voff) do { _Pragma("unroll") for (int _i = 0; _i < 2; ++_i) \
        __builtin_amdgcn_global_load_lds((const unsigned*)((const char*)(gbase) + (voff)[_i]), (LAS unsigned*)(lds + (bufoff) + ldsw + _i * 8192), 16, 0, 0); } while (0)
#define PG8_LDA(dst, b, h) do { _Pragma("unroll") for (int m = 0; m < 4; ++m) _Pragma("unroll") for (int k = 0; k < 2; ++k) dst[m][k] = *(const LAS bf16x8*)(lds + PG8_SA(b, h) + aoff + m * 2048 + k * 1024); } while (0)
#define PG8_LDB(dst, b, h) do { _Pragma("unroll") for (int n = 0; n < 2; ++n) _Pragma("unroll") for (int k = 0; k < 2; ++k) dst[n][k] = *(const LAS bf16x8*)(lds + PG8_SB(b, h) + boff + n * 2048 + k * 1024); } while (0)
#define PG8_MMA(ai, bj, At, Bt) do { __builtin_amdgcn_s_setprio(1); _Pragma("unroll") for (int m = 0; m < 4; ++m) _Pragma("unroll") for (int n = 0; n < 2; ++n) _Pragma("unroll") for (int k = 0; k < 2; ++k) \
        acc[ai][bj][m][n] = __builtin_amdgcn_mfma_f32_16x16x32_bf16(Bt[n][k], At[m][k], acc[ai][bj][m][n], 0, 0, 0); __builtin_amdgcn_s_setprio(0); } while (0)
#define PG8_WAIT_V(n) asm volatile("s_waitcnt vmcnt(" #n ")" ::: "memory")
#define PG8_WAIT_L(n) asm volatile("s_waitcnt lgkmcnt(" #n ")" ::: "memory")
#define PG8_BAR __builtin_amdgcn_s_barrier()
#define PG8_SCHED __builtin_amdgcn_sched_barrier(0)
    Unit cur, nxt; int ui = 0;
    if (!S.next(0, cur)) return;
    f32x4 acc[2][2][4][2];
#pragma unroll
    for (int a = 0; a < 2; ++a)
#pragma unroll
        for (int b = 0; b < 2; ++b)
#pragma unroll
            for (int m = 0; m < 4; ++m)
#pragma unroll
                for (int n = 0; n < 2; ++n) acc[a][b][m][n] = (f32x4){0.f, 0.f, 0.f, 0.f};
    bf16x8 At[4][2], B0[2][2], B1[2][2];
    const char* cA = (const char*)g.A + (size_t)cur.pm * tstepA + (size_t)cur.kt0 * kstep; const char* cB = (const char*)g.Bt + (size_t)cur.pn * tstepB + (size_t)cur.kt0 * kstep;
    PG8_STAGE(PG8_SB(0, 0), cB, voffB); PG8_STAGE(PG8_SA(0, 0), cA, voffA); PG8_STAGE(PG8_SB(0, 1), cB + hstepB, voffB); PG8_STAGE(PG8_SA(0, 1), cA + hstepA, voffA);
    E.prefetch(cur, tid, lds + STAGE_BYTES + 256 + wid * 256);
    if (wr == 1) PG8_BAR;
    PG8_WAIT_V(4); PG8_BAR;
    PG8_STAGE(PG8_SB(1, 0), cB + kstep, voffB); PG8_STAGE(PG8_SA(1, 0), cA + kstep, voffA); PG8_STAGE(PG8_SB(1, 1), cB + hstepB + kstep, voffB);
    PG8_WAIT_V(6); PG8_BAR;
    for (;;) {
        const bool has_next = S.next(ui + 1, nxt);
        const char* nA = has_next ? (const char*)g.A + (size_t)nxt.pm * tstepA + (size_t)nxt.kt0 * kstep : cA; const char* nB = has_next ? (const char*)g.Bt + (size_t)nxt.pn * tstepB + (size_t)nxt.kt0 * kstep : cB;
        const int nt = cur.nkt;
        for (int t = 0; t < nt; t += 2) {
            const bool last = (t == nt - 2);
            const char* a1 = cA + (size_t)(t + 1) * kstep;
            const char* a2 = last ? nA : cA + (size_t)(t + 2) * kstep; const char* b2 = last ? nB : cB + (size_t)(t + 2) * kstep;
            const char* a3 = a2 + kstep; const char* b3 = b2 + kstep;
            PG8_LDB(B0, 0, 0); PG8_SCHED; PG8_LDA(At, 0, 0); PG8_STAGE(PG8_SA(1, 1), a1 + hstepA, voffA);
            PG8_WAIT_L(8); PG8_BAR; PG8_WAIT_L(0); PG8_MMA(0, 0, At, B0); PG8_BAR; PG8_SCHED;
            PG8_LDB(B1, 0, 1); PG8_STAGE(PG8_SB(0, 0), b2, voffB);
            PG8_BAR; PG8_WAIT_L(0); PG8_MMA(0, 1, At, B1); PG8_BAR;
            PG8_LDA(At, 0, 1); PG8_STAGE(PG8_SA(0, 0), a2, voffA);
            PG8_BAR; PG8_WAIT_L(0); PG8_MMA(1, 0, At, B0); PG8_BAR; PG8_SCHED;
            PG8_STAGE(PG8_SB(0, 1), b2 + hstepB, voffB);
            PG8_WAIT_V(6); PG8_BAR; PG8_MMA(1, 1, At, B1); PG8_BAR;
            PG8_LDB(B0, 1, 0); PG8_SCHED; PG8_LDA(At, 1, 0); PG8_STAGE(PG8_SA(0, 1), a2 + hstepA, voffA);
            PG8_WAIT_L(8); PG8_BAR; PG8_WAIT_L(0); PG8_MMA(0, 0, At, B0); PG8_BAR; PG8_SCHED;
            PG8_LDB(B1, 1, 1); PG8_STAGE(PG8_SB(1, 0), b3, voffB);
            PG8_BAR; PG8_WAIT_L(0); PG8_MMA(0, 1, At, B1); PG8_BAR;
            PG8_LDA(At, 1, 1); PG8_STAGE(PG8_SA(1, 0), a3, voffA);
            PG8_BAR; PG8_WAIT_L(0); PG8_MMA(1, 0, At, B0); PG8_BAR; PG8_SCHED;
            PG8_STAGE(PG8_SB(1, 1), b3 + hstepB, voffB);
            PG8_WAIT_V(6); PG8_BAR; PG8_MMA(1, 1, At, B1); PG8_BAR;
        }
        E(acc, cur, wr, wc, fr, fq);
        if (!has_next) break;
#pragma unroll
        for (int a = 0; a < 2; ++a)
#pragma unroll
            for (int b = 0; b < 2; ++b)
#pragma unroll
                for (int m = 0; m < 4; ++m)
#pragma unroll
                    for (int n = 0; n < 2; ++n) acc[a][b][m][n] = (f32x4){0.f, 0.f, 0.f, 0.f};
        cur = nxt; cA = nA; cB = nB; ++ui;
    }
    PG8_WAIT_V(0);
    if (wr == 0) PG8_BAR;
    PG8_BAR;
#undef PG8_SA
#undef PG8_SB
#undef PG8_STAGE
#undef PG8_LDA
#undef PG8_LDB
#undef PG8_MMA
#undef PG8_WAIT_V
#undef PG8_WAIT_L
#undef PG8_BAR
#undef PG8_SCHED
}
}

__device__ __forceinline__ void unpack8(u32x4 w, float (&f)[8]) {
  f[0] = bf_lo(w.x); f[1] = bf_hi(w.x); f[2] = bf_lo(w.y); f[3] = bf_hi(w.y); f[4] = bf_lo(w.z); f[5] = bf_hi(w.z); f[6] = bf_lo(w.w); f[7] = bf_hi(w.w);
}
__device__ __forceinline__ u32x4 pack8(const float (&f)[8]) {
  u32x4 w; w.x = cvt_pk_bf16(f[0], f[1]); w.y = cvt_pk_bf16(f[2], f[3]); w.z = cvt_pk_bf16(f[4], f[5]); w.w = cvt_pk_bf16(f[6], f[7]); return w;
}
__device__ __forceinline__ void ld8f(const float* p, float (&f)[8]) { const f32x4 a = *(const f32x4*)p, b = *(const f32x4*)(p + 4); f[0] = a.x; f[1] = a.y; f[2] = a.z; f[3] = a.w; f[4] = b.x; f[5] = b.y; f[6] = b.z; f[7] = b.w; }
namespace att {
constexpr int NW = 8, QBLK = 32, KVBLK = 64;
constexpr float THR = 8.f;
constexpr int SHM_V = KVBLK * 128 * 2;
constexpr int K_OFF = 2 * SHM_V, WS_OFF = K_OFF + 2 * KVBLK * 192 * 2, QX_OFF = WS_OFF + NW * 64 * 4;
#define SBAR() __builtin_amdgcn_sched_barrier(0)
__device__ __forceinline__ int crow(int r, int hi) { return (r & 3) + 8 * (r >> 2) + 4 * hi; }
template <int DQK> struct SC { };
template <> struct SC<64>  { static constexpr float SCALE = 0.125f; };
template <> struct SC<128> { static constexpr float SCALE = 0.088388347648318440f; };
template <> struct SC<192> { static constexpr float SCALE = 0.072168783648703220f; };

template <int DQK>
__device__ __forceinline__ void partialSM(f32x16& p0, f32x16& p1, float& m_reg, float& mn, float& alpha, bool msk, int kq0, int hi) {
  constexpr float SCALE = SC<DQK>::SCALE;
  constexpr float C = SCALE * 1.4426950408889634f;
  if (msk) {
#pragma unroll
    for (int r = 0; r < 16; ++r) { const int d0 = kq0 + crow(r, hi);
      if ((unsigned)(d0 + 128) > 256u) p0[r] = -1e30f;
      if ((unsigned)(d0 + 32 + 128) > 256u) p1[r] = -1e30f; }
  }
  float pmax = p0[0];
#pragma unroll
  for (int r = 1; r < 16; ++r) pmax = fmaxf(pmax, p0[r]);
#pragma unroll
  for (int r = 0; r < 16; ++r) pmax = fmaxf(pmax, p1[r]);
  { auto rr = __builtin_amdgcn_permlane32_swap(__float_as_uint(pmax), __float_as_uint(pmax), false, false);
    pmax = fmaxf(__uint_as_float(rr[0]), __uint_as_float(rr[1])); }
  if (__builtin_expect(__all(pmax - m_reg <= THR / SCALE), 1)) { mn = m_reg; alpha = 1.f; }
  else { mn = fmaxf(m_reg, pmax); alpha = __builtin_amdgcn_exp2f((m_reg - mn) * C); m_reg = mn; }
  const float mnC = -mn * C;
#pragma unroll
  for (int r = 0; r < 16; ++r) p0[r] = fmaf(p0[r], C, mnC);
#pragma unroll
  for (int r = 0; r < 16; ++r) p1[r] = fmaf(p1[r], C, mnC);
#pragma unroll
  for (int r = 0; r < 16; ++r) p0[r] = __builtin_amdgcn_exp2f(p0[r]);
}
__device__ __forceinline__ void finishSM(f32x16& p0, f32x16& p1, float alpha, float& l_reg, bf16x8& pa0, bf16x8& pa1, bf16x8& pa2, bf16x8& pa3) {
#pragma unroll
  for (int r = 0; r < 16; ++r) p1[r] = __builtin_amdgcn_exp2f(p1[r]);
  float ps = 0;
#pragma unroll
  for (int r = 0; r < 16; ++r) ps += p0[r];
#pragma unroll
  for (int r = 0; r < 16; ++r) ps += p1[r];
  { auto rr = __builtin_amdgcn_permlane32_swap(__float_as_uint(ps), __float_as_uint(ps), false, false);
    ps = __uint_as_float(rr[0]) + __uint_as_float(rr[1]); }
  l_reg = l_reg * alpha + ps;
#define PK4(P, BASE, OUT) do { unsigned a0 = cvt_pk_bf16(P[BASE + 0], P[BASE + 1]), a1 = cvt_pk_bf16(P[BASE + 2], P[BASE + 3]);   \
    unsigned b0 = cvt_pk_bf16(P[BASE + 4], P[BASE + 5]), b1 = cvt_pk_bf16(P[BASE + 6], P[BASE + 7]);                              \
    auto r0 = __builtin_amdgcn_permlane32_swap(a0, b0, false, false); auto r1 = __builtin_amdgcn_permlane32_swap(a1, b1, false, false); \
    u32x4 w = {r0[0], r1[0], r0[1], r1[1]}; OUT = *reinterpret_cast<bf16x8*>(&w); } while (0)
  PK4(p0, 0, pa0); PK4(p0, 8, pa1); PK4(p1, 0, pa2); PK4(p1, 8, pa3);
#undef PK4
}
#define KSW_(dqk, row) ((dqk) == 128 ? (((row) & 15) << 4) : ((((row) >> 1) & 7) << 4))
template <int DQK>
__device__ __forceinline__ void qkt(f32x16& p0, f32x16& p1, const char* Ks, const bf16x8* qr, const char* qx, int r32, int hi) {
  constexpr int RB = DQK * 2, NQR = DQK == 192 ? 8 : DQK / 16;
  p0 = f32x16{}; p1 = f32x16{};
  const int sw = KSW_(DQK, r32);
#pragma unroll
  for (int d0 = 0; d0 < DQK / 16; ++d0) { const int cb = (d0 * 16 + hi * 8) * 2;
    bf16x8 b0 = *reinterpret_cast<const bf16x8*>(Ks + r32 * RB + (cb ^ sw));
    bf16x8 b1 = *reinterpret_cast<const bf16x8*>(Ks + (32 + r32) * RB + (cb ^ sw));
    bf16x8 q;
    if (d0 < NQR) q = qr[d0 < NQR ? d0 : 0]; else q = *reinterpret_cast<const bf16x8*>(qx + ((((d0 - NQR) * 2 + hi) * 16) ^ ((r32 & 7) << 4)));
    p0 = __builtin_amdgcn_mfma_f32_32x32x16_bf16(b0, q, p0, 0, 0, 0);
    p1 = __builtin_amdgcn_mfma_f32_32x32x16_bf16(b1, q, p1, 0, 0, 0); }
}
__device__ __forceinline__ int v_st(int k, int c) { const int kk = (k & ~0xC) | ((k & 4) << 1) | ((k & 8) >> 1); return ((kk >> 3) * 4 + (c >> 5)) * 512 + ((kk & 7) * 32 + (c & 31)) * 2; }
__device__ __forceinline__ int v_rd_base(int lane) { return ((lane & 3) << 3) | (((lane >> 2) & 3) << 6) | (((lane >> 4) & 1) << 5) | (((lane >> 5) & 1) << 8); }
constexpr int v_rd_off(int d0, int ks, int half) { return d0 * 512 + ks * 4096 + half * 2048; }
template <int OFF> __device__ __forceinline__ s16x4 tr_read(int vb) {
  s16x4 r; asm volatile("ds_read_b64_tr_b16 %0, %1 offset:%2" : "=&v"(r) : "v"(vb), "i"(OFF) : "memory"); return r;
}
template <int D0> __device__ __forceinline__ void pv_one(f32x16& od, int vb, bf16x8 pa0, bf16x8 pa1, bf16x8 pa2, bf16x8 pa3) {
  const s16x4 l0 = tr_read<v_rd_off(D0, 0, 0)>(vb), h0 = tr_read<v_rd_off(D0, 0, 1)>(vb), l1 = tr_read<v_rd_off(D0, 1, 0)>(vb), h1 = tr_read<v_rd_off(D0, 1, 1)>(vb);
  const s16x4 l2 = tr_read<v_rd_off(D0, 2, 0)>(vb), h2 = tr_read<v_rd_off(D0, 2, 1)>(vb), l3 = tr_read<v_rd_off(D0, 3, 0)>(vb), h3 = tr_read<v_rd_off(D0, 3, 1)>(vb);
  asm volatile("s_waitcnt lgkmcnt(0)" ::: "memory"); SBAR();
#define PK(L, H) (bf16x8){L[0], L[1], L[2], L[3], H[0], H[1], H[2], H[3]}
  od = __builtin_amdgcn_mfma_f32_32x32x16_bf16(pa0, PK(l0, h0), od, 0, 0, 0);
  od = __builtin_amdgcn_mfma_f32_32x32x16_bf16(pa1, PK(l1, h1), od, 0, 0, 0);
  od = __builtin_amdgcn_mfma_f32_32x32x16_bf16(pa2, PK(l2, h2), od, 0, 0, 0);
  od = __builtin_amdgcn_mfma_f32_32x32x16_bf16(pa3, PK(l3, h3), od, 0, 0, 0);
#undef PK
}
__device__ __forceinline__ void pv_d0(f32x16* o, int vb, bf16x8 pa0, bf16x8 pa1, bf16x8 pa2, bf16x8 pa3) {
  pv_one<0>(o[0], vb, pa0, pa1, pa2, pa3); pv_one<1>(o[1], vb, pa0, pa1, pa2, pa3); pv_one<2>(o[2], vb, pa0, pa1, pa2, pa3); pv_one<3>(o[3], vb, pa0, pa1, pa2, pa3);
}

template <int DQK, int PIPE, bool WIN, int ldq, int ldk, int ldu>
__device__ __forceinline__ void attn_body(const bf16_t* __restrict__ Qb, const bf16_t* __restrict__ Kh, const bf16_t* __restrict__ Vh,
                                          float* __restrict__ Ob, int NT, int lo, int qpos0, float sink_l2, char* lds,
                                          bf16_t* __restrict__ yb, const bf16_t* __restrict__ ugb, int epi, float lam, float one_m, const float* __restrict__ subg,
                                          const float* __restrict__ qcos, const float* __restrict__ qsin, const float* __restrict__ qg) {
  constexpr int ldo = MIXW;
  constexpr int SDEPTH = (DQK == 64 && PIPE == 2) ? 2 : 1; constexpr bool win = WIN;
  constexpr int RB = DQK * 2, SHM_K = KVBLK * RB, CPR = DQK / 8, NKC = DQK / 64, NQR = DQK == 192 ? 8 : DQK / 16;
  constexpr float C = SC<DQK>::SCALE * 1.4426950408889634f;
  const int tid = otid(), wid = tid >> 6, lane = tid & 63, r32 = lane & 31, hi = lane >> 5;
  char* V_lds = lds; char* K_lds = lds + K_OFF;
  float* ws = (float*)(lds + WS_OFF) + wid * 64; float* li_l = ws; float* al_l = ws + 32;
  float m_reg = -1e30f, l_reg = 0; f32x16 o[4] = {}; bf16x8 qr[NQR];
  const bf16_t* Qw = Qb + (long)(wid * QBLK + r32) * ldq + hi * 8;
#pragma unroll
  for (int d0 = 0; d0 < NQR; ++d0) qr[d0] = *reinterpret_cast<const bf16x8*>(Qw + d0 * 16);
  char* qx = lds + QX_OFF + wid * 4096 + r32 * 128;
  const int sr = ((tid >> 5) << 1) | ((tid >> 2) & 1), sc = ((tid >> 3) & 3) * 32 + (tid & 3) * 8, vst0 = v_st(sr, sc), vst1 = v_st(32 + sr, sc);
  int kgo[NKC], klo[NKC];
#pragma unroll
  for (int c = 0; c < NKC; ++c) { const int id = tid + 512 * c, kr = id / CPR, kc = (id % CPR) * 8; kgo[c] = kr * ldk + kc; klo[c] = kr * RB + ((kc * 2) ^ KSW_(DQK, kr)); }
  const int vb0 = (int)(uintptr_t)V_lds + v_rd_base(lane);
  const int qmy = qpos0 + wid * QBLK + r32 + 256;
  struct { bf16x8 vs0, vs1; bf16x8 ks[NKC]; } sr_[SDEPTH];
#define KROW(t) ((t) * KVBLK + ((win && (t) >= 4) ? lo : 0))
#define SLOAD(i, t) do { const int k0_ = KROW(t); sr_[i].vs0 = *reinterpret_cast<const bf16x8*>(&Vh[(long)(k0_ + sr) * ldk + sc]); sr_[i].vs1 = *reinterpret_cast<const bf16x8*>(&Vh[(long)(k0_ + 32 + sr) * ldk + sc]); \
    _Pragma("unroll") for (int c_ = 0; c_ < NKC; ++c_) sr_[i].ks[c_] = *reinterpret_cast<const bf16x8*>(&Kh[(long)k0_ * ldk + kgo[c_]]); } while (0)
#define SWRITE(b, i) do { *(bf16x8*)(V_lds + (b) * SHM_V + vst0) = sr_[i].vs0; *(bf16x8*)(V_lds + (b) * SHM_V + vst1) = sr_[i].vs1; \
    _Pragma("unroll") for (int c_ = 0; c_ < NKC; ++c_) *(bf16x8*)(K_lds + (b) * SHM_K + klo[c_]) = sr_[i].ks[c_]; } while (0)
#define SWAIT() do { if constexpr (SDEPTH == 1) asm volatile("s_waitcnt vmcnt(0)" ::: "memory"); else if constexpr (NKC == 1) asm volatile("s_waitcnt vmcnt(3)" ::: "memory"); else if constexpr (NKC == 2) asm volatile("s_waitcnt vmcnt(4)" ::: "memory"); else asm volatile("s_waitcnt vmcnt(5)" ::: "memory"); } while (0)
#define RESC(a) do { if (__any((a) < 1.f)) { if (hi == 0) al_l[r32] = (a); asm volatile("s_waitcnt lgkmcnt(0)" ::: "memory"); \
    _Pragma("unroll") for (int d = 0; d < 4; ++d) _Pragma("unroll") for (int r = 0; r < 16; ++r) o[d][r] *= al_l[crow(r, hi)]; } } while (0)
#define PSM(P0, P1, MN, AL, t) partialSM<DQK>(P0, P1, m_reg, MN, AL, win && (t) >= 4, KROW(t) - qmy, hi)
  bf16x8 pa0, pa1, pa2, pa3;
  if constexpr (PIPE == 2) {
  f32x16 pA0, pA1, pB0, pB1; float mnA, mnB, alA, alB;
  constexpr int SE = 0, SO = SDEPTH - 1;
  SLOAD(SE, 0);
  if (qg != nullptr) {
    float ss = 0.f;
#pragma unroll
    for (int d0 = 0; d0 < NQR; ++d0) { float x[8]; unpack8(*reinterpret_cast<u32x4*>(&qr[d0]), x);
#pragma unroll
      for (int k = 0; k < 8; ++k) ss += x[k] * x[k]; }
    ss += __shfl_xor(ss, 32);
    const float rstd = rsqrtf(ss * (1.f / DQK) + EPS);
#pragma unroll
    for (int d0 = 0; d0 < NQR; ++d0) { float x[8], g8[8]; unpack8(*reinterpret_cast<u32x4*>(&qr[d0]), x); ld8f(qg + d0 * 16 + hi * 8, g8);
#pragma unroll
      for (int k = 0; k < 8; ++k) x[k] = x[k] * rstd * g8[k];
      u32x4 w = pack8(x); qr[d0] = *reinterpret_cast<bf16x8*>(&w); }
  }
  if (DQK != 192 && qcos != nullptr) {
    const int sq = qpos0 + wid * QBLK + r32;
#pragma unroll
    for (int d0 = 0; d0 < NQR / 2; ++d0) { const int i0 = d0 * 16 + hi * 8; float c_[8], s_[8], x1[8], x2[8];
      ld8f(qcos + (size_t)sq * (DQK / 2) + i0, c_); ld8f(qsin + (size_t)sq * (DQK / 2) + i0, s_);
      unpack8(*reinterpret_cast<u32x4*>(&qr[d0]), x1); unpack8(*reinterpret_cast<u32x4*>(&qr[d0 + NQR / 2]), x2);
#pragma unroll
      for (int k = 0; k < 8; ++k) { const float a = x1[k], b = x2[k]; x1[k] = a * c_[k] - b * s_[k]; x2[k] = a * s_[k] + b * c_[k]; }
      u32x4 w1 = pack8(x1), w2 = pack8(x2); qr[d0] = *reinterpret_cast<bf16x8*>(&w1); qr[d0 + NQR / 2] = *reinterpret_cast<bf16x8*>(&w2); }
  }
  if constexpr (DQK == 192) {
    bf16x8 qp[4];
#pragma unroll
    for (int j = 0; j < 4; ++j) qp[j] = *reinterpret_cast<const bf16x8*>(Qw + (NQR + j) * 16);
    if (qcos != nullptr) { const int sq = qpos0 + wid * QBLK + r32;
#pragma unroll
      for (int j = 0; j < 2; ++j) { const int i0 = j * 16 + hi * 8; float c_[8], s_[8], x1[8], x2[8];
        ld8f(qcos + (size_t)sq * 32 + i0, c_); ld8f(qsin + (size_t)sq * 32 + i0, s_);
        unpack8(*reinterpret_cast<u32x4*>(&qp[j]), x1); unpack8(*reinterpret_cast<u32x4*>(&qp[j + 2]), x2);
#pragma unroll
        for (int k = 0; k < 8; ++k) { const float a = x1[k], b = x2[k]; x1[k] = a * c_[k] - b * s_[k]; x2[k] = a * s_[k] + b * c_[k]; }
        u32x4 w1 = pack8(x1), w2 = pack8(x2); qp[j] = *reinterpret_cast<bf16x8*>(&w1); qp[j + 2] = *reinterpret_cast<bf16x8*>(&w2); } }
#pragma unroll
    for (int j = 0; j < 4; ++j) *reinterpret_cast<bf16x8*>(qx + (((j * 2 + hi) * 16) ^ ((r32 & 7) << 4))) = qp[j];
  }
  asm volatile("s_waitcnt vmcnt(0)" ::: "memory"); SWRITE(0, SE); __syncthreads();
  qkt<DQK>(pA0, pA1, K_lds, qr, qx, r32, hi); PSM(pA0, pA1, mnA, alA, 0);
  SLOAD(SO, 1); if constexpr (SDEPTH == 2) { if (2 < NT) SLOAD(SE, 2); }
  SWAIT(); SWRITE(1, SO); __syncthreads();
  for (int j = 1; j + 1 < NT; j += 2) {
    if (j == NT - 5 && epi != 1) __builtin_amdgcn_global_load_lds((const unsigned*)(ugb + (long)(tid >> 1) * ldu + (tid & 1) * 64), (LAS unsigned*)(lds + LDS_MAIN + 256 + wid * 256), 4, 0, 0);
    SBAR(); qkt<DQK>(pB0, pB1, K_lds + SHM_K, qr, qx, r32, hi);
    finishSM(pA0, pA1, alA, l_reg, pa0, pa1, pa2, pa3); SBAR();
    SLOAD(SO, j + SDEPTH); SBAR();
    pv_d0(o, vb0, pa0, pa1, pa2, pa3); PSM(pB0, pB1, mnB, alB, j);
    __syncthreads(); SWAIT(); SWRITE(0, SE);
    RESC(alB); __syncthreads();
    SBAR(); qkt<DQK>(pA0, pA1, K_lds, qr, qx, r32, hi);
    finishSM(pB0, pB1, alB, l_reg, pa0, pa1, pa2, pa3); SBAR();
    if (SDEPTH == 1 || j + 3 < NT) SLOAD(SE, j + 1 + SDEPTH); SBAR();
    pv_d0(o, vb0 + SHM_V, pa0, pa1, pa2, pa3); PSM(pA0, pA1, mnA, alA, j + 1);
    __syncthreads(); SWAIT(); SWRITE(1, SO);
    RESC(alA); __syncthreads();
  }
  SBAR(); qkt<DQK>(pB0, pB1, K_lds + SHM_K, qr, qx, r32, hi);
  finishSM(pA0, pA1, alA, l_reg, pa0, pa1, pa2, pa3); SBAR();
  pv_d0(o, vb0, pa0, pa1, pa2, pa3); PSM(pB0, pB1, mnB, alB, NT - 1);
  __syncthreads(); RESC(alB);
  finishSM(pB0, pB1, alB, l_reg, pa0, pa1, pa2, pa3); SBAR();
  pv_d0(o, vb0 + SHM_V, pa0, pa1, pa2, pa3);
  } else {
  f32x16 p0, p1; float mn, al;
  SLOAD(0, 0);
  if (qg != nullptr) {
    float ss = 0.f;
#pragma unroll
    for (int d0 = 0; d0 < NQR; ++d0) { float x[8]; unpack8(*reinterpret_cast<u32x4*>(&qr[d0]), x);
#pragma unroll
      for (int k = 0; k < 8; ++k) ss += x[k] * x[k]; }
    ss += __shfl_xor(ss, 32);
    const float rstd = rsqrtf(ss * (1.f / DQK) + EPS);
#pragma unroll
    for (int d0 = 0; d0 < NQR; ++d0) { float x[8], g8[8]; unpack8(*reinterpret_cast<u32x4*>(&qr[d0]), x); ld8f(qg + d0 * 16 + hi * 8, g8);
#pragma unroll
      for (int k = 0; k < 8; ++k) x[k] = x[k] * rstd * g8[k];
      u32x4 w = pack8(x); qr[d0] = *reinterpret_cast<bf16x8*>(&w); }
  }
  if (DQK != 192 && qcos != nullptr) {
    const int sq = qpos0 + wid * QBLK + r32;
#pragma unroll
    for (int d0 = 0; d0 < NQR / 2; ++d0) { const int i0 = d0 * 16 + hi * 8; float c_[8], s_[8], x1[8], x2[8];
      ld8f(qcos + (size_t)sq * (DQK / 2) + i0, c_); ld8f(qsin + (size_t)sq * (DQK / 2) + i0, s_);
      unpack8(*reinterpret_cast<u32x4*>(&qr[d0]), x1); unpack8(*reinterpret_cast<u32x4*>(&qr[d0 + NQR / 2]), x2);
#pragma unroll
      for (int k = 0; k < 8; ++k) { const float a = x1[k], b = x2[k]; x1[k] = a * c_[k] - b * s_[k]; x2[k] = a * s_[k] + b * c_[k]; }
      u32x4 w1 = pack8(x1), w2 = pack8(x2); qr[d0] = *reinterpret_cast<bf16x8*>(&w1); qr[d0 + NQR / 2] = *reinterpret_cast<bf16x8*>(&w2); }
  }
  if constexpr (DQK == 192) {
    bf16x8 qp[4];
#pragma unroll
    for (int j = 0; j < 4; ++j) qp[j] = *reinterpret_cast<const bf16x8*>(Qw + (NQR + j) * 16);
    if (qcos != nullptr) { const int sq = qpos0 + wid * QBLK + r32;
#pragma unroll
      for (int j = 0; j < 2; ++j) { const int i0 = j * 16 + hi * 8; float c_[8], s_[8], x1[8], x2[8];
        ld8f(qcos + (size_t)sq * 32 + i0, c_); ld8f(qsin + (size_t)sq * 32 + i0, s_);
        unpack8(*reinterpret_cast<u32x4*>(&qp[j]), x1); unpack8(*reinterpret_cast<u32x4*>(&qp[j + 2]), x2);
#pragma unroll
        for (int k = 0; k < 8; ++k) { const float a = x1[k], b = x2[k]; x1[k] = a * c_[k] - b * s_[k]; x2[k] = a * s_[k] + b * c_[k]; }
        u32x4 w1 = pack8(x1), w2 = pack8(x2); qp[j] = *reinterpret_cast<bf16x8*>(&w1); qp[j + 2] = *reinterpret_cast<bf16x8*>(&w2); } }
#pragma unroll
    for (int j = 0; j < 4; ++j) *reinterpret_cast<bf16x8*>(qx + (((j * 2 + hi) * 16) ^ ((r32 & 7) << 4))) = qp[j];
  }
  asm volatile("s_waitcnt vmcnt(0)" ::: "memory"); SWRITE(0, 0); __syncthreads();
  for (int j = 0; j < NT; ++j) {
    const int cur = j & 1; const bool more = j + 1 < NT;
    if (j == NT - 4 && epi != 1) __builtin_amdgcn_global_load_lds((const unsigned*)(ugb + (long)(tid >> 1) * ldu + (tid & 1) * 64), (LAS unsigned*)(lds + LDS_MAIN + 256 + wid * 256), 4, 0, 0);
    if (more) SLOAD(0, j + 1);
    SBAR();
    qkt<DQK>(p0, p1, K_lds + cur * SHM_K, qr, qx, r32, hi);
    PSM(p0, p1, mn, al, j);
    RESC(al);
    finishSM(p0, p1, al, l_reg, pa0, pa1, pa2, pa3); SBAR();
    pv_d0(o, vb0 + cur * SHM_V, pa0, pa1, pa2, pa3);
    if (more) SWRITE(cur ^ 1, 0);
    __syncthreads();
  }
  }
  l_reg += __builtin_amdgcn_exp2f(sink_l2 - m_reg * C);
  if (hi == 0) li_l[r32] = l_reg; asm volatile("s_waitcnt lgkmcnt(0)" ::: "memory");
  float rli[16];
#pragma unroll
  for (int r = 0; r < 16; ++r) rli[r] = __builtin_amdgcn_rcpf(li_l[crow(r, hi)]);
  if (epi == 1) {
    float* Sw = Ob + wid * 4096 + lane;
#pragma unroll
    for (int r = 0; r < 16; ++r)
#pragma unroll
      for (int d0 = 0; d0 < 4; ++d0) Sw[(r * 4 + d0) * 64] = o[d0][r] * rli[r];
  } else {
    constexpr int GST = 272;
    __syncthreads();
    const int tid_e = otid(), gr = tid_e >> 4, gc = (tid_e & 15) * 8;
#pragma unroll
    for (int hh = 0; hh < 2; ++hh) {
      bf16x8 gv[4];
#pragma unroll
      for (int i2 = 0; i2 < 4; ++i2) gv[i2] = *reinterpret_cast<const bf16x8*>(ugb + (long)(gr + 32 * (hh * 4 + i2)) * ldu + gc);
#pragma unroll
      for (int i2 = 0; i2 < 4; ++i2) *reinterpret_cast<bf16x8*>(lds + (gr + 32 * (hh * 4 + i2)) * GST + gc * 2) = gv[i2];
      asm volatile("" ::: "memory");
    }
    if (epi == 2) {
      const float* Sw = Ob + wid * 4096 + lane;
      float sg[4];
#pragma unroll
      for (int d0 = 0; d0 < 4; ++d0) sg[d0] = subg[d0 * 32 + r32] * one_m;
#pragma unroll
      for (int r = 0; r < 16; ++r) { float ss = 0.f;
#pragma unroll
        for (int d0 = 0; d0 < 4; ++d0) { const float v = Sw[(r * 4 + d0) * 64] - lam * (o[d0][r] * rli[r]); o[d0][r] = v; ss += v * v; }
#pragma unroll
        for (int of = 1; of < 32; of <<= 1) ss += __shfl_xor(ss, of);
        const float rstd = rsqrtf(ss * (1.f / 128.f) + EPS);
#pragma unroll
        for (int d0 = 0; d0 < 4; ++d0) o[d0][r] *= rstd * sg[d0];
        rli[r] = 1.f;
        if ((r & 3) == 3) asm volatile("" ::: "memory"); }
    }
    __syncthreads();
#pragma unroll
    for (int r = 0; r < 16; ++r) { char* prow = lds + (wid * QBLK + crow(r, hi)) * GST + r32 * 2;
#pragma unroll
      for (int d0 = 0; d0 < 4; ++d0) { bf16_t* p = reinterpret_cast<bf16_t*>(prow + d0 * 64); const float gte = __uint_as_float((unsigned)(*p) << 16);
        *p = (bf16_t)(cvt_pk_bf16(o[d0][r] * rli[r] * silu_f(gte), 0.f) & 0xffffu); } }
    __syncthreads();
#pragma unroll
    for (int i2 = 0; i2 < 8; ++i2) *reinterpret_cast<bf16x8*>(yb + (long)(gr + 32 * i2) * DM + gc) = *reinterpret_cast<const bf16x8*>(lds + (gr + 32 * i2) * GST + gc * 2);
  }
#undef KROW
#undef SLOAD
#undef SWRITE
#undef SWAIT
#undef RESC
#undef PSM
}
}

__device__ __forceinline__ float wave_sum(float v) {
#pragma unroll
  for (int o = 1; o < 64; o <<= 1) v += __shfl_xor(v, o);
  return v;
}
__device__ __forceinline__ void sincos_acc(float ang, float& c, float& s) {
  const double a = (double)ang; const double n = rint(a * 0.15915494309189533577); const double r = a - n * 6.283185307179586476925;
  const double r2 = r * r; double ts = r, tc = 1.0, ss = 0.0, cc = 0.0;
#pragma unroll
  for (int k = 1; k <= 13; ++k) { ss += ts; cc += tc; tc *= -r2 / (double)((2 * k - 1) * (2 * k)); ts *= -r2 / (double)((2 * k) * (2 * k + 1)); }
  s = (float)ss; c = (float)cc;
}

__device__ __forceinline__ void p0_transpose_item(const float* W, int Nsrc, int K, bf16_t* WT, int k0, int n_dst0, int n_src0, float* scr, int lane) {
  if (n_src0 >= 0) {
    float v[32]; const float* wp = W + (size_t)(k0 + (lane >> 5)) * Nsrc + n_src0 + (lane & 31);
#pragma unroll
    for (int i = 0; i < 32; ++i) v[i] = wp[(size_t)(2 * i) * Nsrc];
#pragma unroll
    for (int i = 0; i < 32; ++i) scr[(2 * i + (lane >> 5)) * 33 + (lane & 31)] = v[i];
  } else {
#pragma unroll 8
    for (int i = 0; i < 32; ++i) { const int kk = 2 * i + (lane >> 5); scr[kk * 33 + (lane & 31)] = 0.f; }
  }
  asm volatile("s_waitcnt lgkmcnt(0)" ::: "memory");
  const int c = lane & 7;
#pragma unroll
  for (int j = 0; j < 4; ++j) { const int n = (lane >> 3) + 8 * j; const float* s = scr + (8 * c) * 33 + n;
    u32x4 o; o.x = cvt_pk_bf16(s[0 * 33], s[1 * 33]); o.y = cvt_pk_bf16(s[2 * 33], s[3 * 33]); o.z = cvt_pk_bf16(s[4 * 33], s[5 * 33]); o.w = cvt_pk_bf16(s[6 * 33], s[7 * 33]);
    *(u32x4*)(WT + (size_t)(n_dst0 + n) * K + k0 + 8 * c) = o; }
  asm volatile("s_waitcnt lgkmcnt(0)" ::: "memory");
}

__device__ __forceinline__ void job_mod(const Params& P, char* lds, int l, int rank, int nranks) {
  const int tid = otid(), lane = tid & 63, wave = tid >> 6;
  float* sv = (float*)lds; float* red = sv + 3 * 2048;
  float* mod = (float*)(P.ws + WS_MOD);
  if (rank >= 96) return;
  for (int i = tid; i < 6144; i += NTHREADS) { const int v = i >> 11, k = i & 2047; const float x = v < 2 ? P.in[I_C][v * 2048 + k] : P.in[I_CCTX][k]; sv[i] = silu_f(x); }
  __syncthreads();
  for (int nb = rank; nb < 96; nb += nranks) {
    const int cgi = lane & 15, ks = lane >> 4;
    const float* W = P.in[I_WMOD] + (size_t)l * 2048 * 6144 + nb * 64 + cgi * 4;
    f32x4 a0 = {0, 0, 0, 0}, a1 = {0, 0, 0, 0}, a2 = {0, 0, 0, 0};
#pragma unroll 16
    for (int i = 0; i < 64; ++i) { const int k = wave * 256 + ks + 4 * i; const f32x4 wv = *(const f32x4*)(W + (size_t)k * 6144);
      a0 += sv[k] * wv; a1 += sv[2048 + k] * wv; a2 += sv[4096 + k] * wv; }
    const int pi = wave * 4 + ks;
    *(f32x4*)(red + (pi * 3 + 0) * 64 + cgi * 4) = a0; *(f32x4*)(red + (pi * 3 + 1) * 64 + cgi * 4) = a1; *(f32x4*)(red + (pi * 3 + 2) * 64 + cgi * 4) = a2;
    __syncthreads();
    if (tid < 192) { const int v = tid >> 6, n = tid & 63; float s = P.in[I_BMOD][l * 6144 + nb * 64 + n];
#pragma unroll
      for (int p = 0; p < 32; ++p) s += red[(p * 3 + v) * 64 + n];
      mod[(size_t)(l * 3 + v) * 6144 + nb * 64 + n] = s; }
    __syncthreads();
  }
}
__device__ __forceinline__ void job_convert(const Params& P, char* lds, int which, int rank, int nranks) {
  const int tid = otid(), lane = tid & 63, wave = tid >> 6;
  unsigned char* ws = P.ws;
  float* scr = (float*)(lds + wave * 8448);
  __syncthreads();
  const int gw = rank * 8 + wave, NGW = nranks * 8;
  constexpr int I_E = 32 * 208, I_O = 32 * 144, I_W = 32 * 64, I_Q = 8 * 48, I_KV = 4 * 80;
  const int n_main = which == 0 ? 2 * (I_E + I_O + I_Q + I_KV) : 0, nitems = n_main + I_W;
  for (int it = gw; it < nitems; it += NGW) {
    int r = it;
    if (r >= n_main) { r -= n_main; const int kb = r / 64, nb = r % 64;
      p0_transpose_item(P.in[I_WO] + (size_t)which * DM * DM, DM, DM, (bf16_t*)(ws + WS_WOUT) + (size_t)which * DM * DM, kb * 64, nb * 32, nb * 32, scr, lane); continue; }
    if (r < 2 * I_E) { const int i = r / I_E; r %= I_E; const int kb = r / 208, nb = r % 208; const int nd = nb * 32; int ns = nd;
      if (nd >= 1024 && nd < 2048) { const int tl = (nd - 1024) >> 8, p = (nd - 1024) & 255, bj = p >> 7, uu = (p & 127) >> 5; ns = 1024 + tl * 256 + uu * 64 + bj * 32; }
      else if (nd >= 4096 && nd < 4352) { const int p = nd - 4096, bj = p >> 7, hh = (p & 127) >> 6, i0 = p & 63; ns = 4096 + hh * 128 + bj * 64 + i0; }
      p0_transpose_item(P.in[I_EWIN] + (size_t)i * DM * EVEN_N, EVEN_N, DM, (bf16_t*)(ws + WS_WE) + (size_t)i * EVEN_N * DM, kb * 64, nd, ns, scr, lane); continue; }
    r -= 2 * I_E;
    if (r < 2 * I_O) { const int i = r / I_O; r %= I_O; const int kb = r / 144, nb = r % 144; const int nd = nb * 32; const int ns = nd < 2368 ? nd : (nd < 2560 ? -1 : nd - 192);
      p0_transpose_item(P.in[I_OWIN] + (size_t)i * DM * ODD_SRC, ODD_SRC, DM, (bf16_t*)(ws + WS_WO_IN) + (size_t)i * ODD_N * DM, kb * 64, nd, ns, scr, lane); continue; }
    r -= 2 * I_O;
    if (r < 2 * I_Q) { const int i = r / I_Q; r %= I_Q; const int kb = r / 48, nb = r % 48;
      p0_transpose_item(P.in[I_DWQB] + (size_t)i * 512 * QD_N, QD_N, 512, (bf16_t*)(ws + WS_WQB) + (size_t)i * QD_N * 512, kb * 64, nb * 32, nb * 32, scr, lane); continue; }
    r -= 2 * I_Q;
    { const int i = r / I_KV; r %= I_KV; const int kb = r / 80, nb = r % 80; const int nd = nb * 32, h = nd / 320, j = nd % 320;
      const int ns = j < 128 ? h * 256 + j : (j < 192 ? -1 : h * 256 + 128 + (j - 192));
      p0_transpose_item(P.in[I_DWKVB] + (size_t)i * 256 * 2048, 2048, 256, (bf16_t*)(ws + WS_WKVB) + (size_t)i * KVD_N * 256, kb * 64, nd, ns, scr, lane); }
  }
}

__device__ __forceinline__ void phase_p0(const Params& P, char* lds) {
  const int tid = otid();
  unsigned char* ws = P.ws;
  const int G = gridDim.x, bx = blockIdx.x;
  job_mod(P, lds, 0, bx, G);
  if (bx == G - 1 && tid < 2) {
    const int i = tid; float s1 = 0.f, s2 = 0.f;
    for (int k = 0; k < 64; ++k) { s1 += P.in[I_LQ1][i * 64 + k] * P.in[I_LK1][i * 64 + k]; s2 += P.in[I_LQ2][i * 64 + k] * P.in[I_LK2][i * 64 + k]; }
    const float lam_init = i == 0 ? 0.2f : 0.47071301834358416f;
    ((float*)(ws + WS_LAM))[i] = expf(s1) - expf(s2) + lam_init;
  }
  {
    float* c128 = (float*)(ws + WS_COS128); float* s128 = (float*)(ws + WS_SIN128); float* c64 = (float*)(ws + WS_COS64); float* s64 = (float*)(ws + WS_SIN64);
    const int gt = bx * NTHREADS + tid, NT_ = G * NTHREADS;
    for (int w = gt; w < SEQ * 96; w += NT_) {
      const int s = w / 96, j = w % 96; const int row = s >> 6, col = s & 63;
      if (j < 64) { const int f = j & 31; const float inv = powf(10000.f, -(float)f / 32.f); const float ang = (float)(j < 32 ? row : col) * inv; float c_, s_; sincos_acc(ang, c_, s_); c128[s * 64 + j] = c_; s128[s * 64 + j] = s_; }
      else { const int jj = j - 64, f = jj & 15; const float inv = powf(10000.f, -(float)f / 16.f); const float ang = (float)(jj < 16 ? row : col) * inv; float c_, s_; sincos_acc(ang, c_, s_); c64[s * 32 + jj] = c_; s64[s * 32 + jj] = s_; }
    }
  }
  job_convert(P, lds, 0, bx, G);
}

__device__ __forceinline__ const float* norm_src(const Params& P, const float* xw, int l, int m) {
  const int b = m / TPB, t = m % TPB;
  if (l == 0 || (l == 1 && t < CTXL)) return t < CTXL ? P.in[I_CTX] + (size_t)(b * CTXL + t) * DM : P.in[I_X] + (size_t)(b * SEQ + (t - CTXL)) * DM;
  return xw + (size_t)m * DM;
}
__device__ __forceinline__ void phase_norm(const Params& P, int l) {
  const int tid = otid(), lane = tid & 63, wave = tid >> 6;
  float* xw = (float*)(P.ws + WS_XW); bf16_t* h = (bf16_t*)(P.ws + WS_H); const float* part = (const float*)(P.ws + WS_PART);
  const float* mod = (const float*)(P.ws + WS_MOD) + (size_t)l * 3 * 6144; const float* g = P.in[I_NORMG] + l * DM;
  const int nwv = gridDim.x * 8, gwv = blockIdx.x * 8 + wave; const bool split = (l > 0) && nwv >= 1024;
#define NORM_ROW(q) (!split ? (gwv + (q) * nwv) : (gwv < 512 ? ((q) == 0 ? (gwv >> 8) * TPB + (gwv & 255) : MTOK) : \
    (((gwv - 512) + (q) * (nwv - 512)) < NB * SEQ ? (((gwv - 512) + (q) * (nwv - 512)) >> 12) * TPB + CTXL + (((gwv - 512) + (q) * (nwv - 512)) & 4095) : MTOK)))
  int qi = 0;
  int m = NORM_ROW(0);
  f32x4 xn[8], av[8], bv[8]; int vcur = -1;
#pragma unroll
  for (int j = 0; j < 8; ++j) { av[j] = (f32x4){0.f, 0.f, 0.f, 0.f}; bv[j] = (f32x4){0.f, 0.f, 0.f, 0.f}; }
  f32x4 xn2[8];
  if (m < MTOK) { const float* xr = norm_src(P, xw, l, m) + lane * 4;
#pragma unroll
    for (int j = 0; j < 8; ++j) xn[j] = *(const f32x4*)(xr + 256 * j); }
  int m1 = NORM_ROW(1);
  if (m1 < MTOK) { const float* xr = norm_src(P, xw, l, m1) + lane * 4;
#pragma unroll
    for (int j = 0; j < 8; ++j) xn2[j] = *(const f32x4*)(xr + 256 * j); }
  qi = 1;
  while (m < MTOK) {
    const int b = m / TPB, t = m % TPB, v = t < CTXL ? 2 : b;
    if (v != vcur) { vcur = v; const float* sh = mod + v * 6144 + lane * 4;
#pragma unroll
      for (int j = 0; j < 8; ++j) { const f32x4 gg = *(const f32x4*)(g + lane * 4 + 256 * j), s1 = *(const f32x4*)(sh + 2048 + 256 * j); av[j] = gg * (1.f + s1); bv[j] = *(const f32x4*)(sh + 256 * j); } }
    f32x4 x[8]; float ss = 0.f;
#pragma unroll
    for (int j = 0; j < 8; ++j) { x[j] = xn[j]; xn[j] = xn2[j]; }
    const int mnext = m1; ++qi; m1 = NORM_ROW(qi);
    if (m1 < MTOK) { const float* xr = norm_src(P, xw, l, m1) + lane * 4;
#pragma unroll
      for (int j = 0; j < 8; ++j) xn2[j] = *(const f32x4*)(xr + 256 * j); }
    if (l > 0 && t < CTXL) {
      const float* pr = part + (size_t)(b * 256 + t) * DM + lane * 4;
#pragma unroll
      for (int k = 0; k < 8; ++k) {
#pragma unroll
        for (int j = 0; j < 8; ++j) x[j] += *(const f32x4*)(pr + (size_t)k * 512 * DM + 256 * j); }
      float* xo = xw + (size_t)m * DM + lane * 4;
#pragma unroll
      for (int j = 0; j < 8; ++j) *(f32x4*)(xo + 256 * j) = x[j];
    }
#pragma unroll
    for (int j = 0; j < 8; ++j) { ss += (x[j].x * x[j].x + x[j].y * x[j].y) + (x[j].z * x[j].z + x[j].w * x[j].w); }
    const float rstd = rsqrtf(wave_sum(ss) * (1.f / DM) + EPS);
#pragma unroll
    for (int j = 0; j < 8; ++j) {
      const f32x4 y = (x[j] * rstd) * av[j] + bv[j];
      u32x2 w; w.x = cvt_pk_bf16(y.x, y.y); w.y = cvt_pk_bf16(y.z, y.w);
      *(u32x2*)(h + (size_t)m * DM + lane * 4 + 256 * j) = w; }
    m = mnext;
  }
}

__device__ __forceinline__ void rope8(float (&x1)[8], float (&x2)[8], const float* cosp, const float* sinp) {
  float c[8], s[8]; ld8f(cosp, c); ld8f(sinp, s);
#pragma unroll
  for (int i = 0; i < 8; ++i) { const float a = x1[i], b = x2[i]; x1[i] = a * c[i] - b * s[i]; x2[i] = a * s[i] + b * c[i]; }
}

__device__ __forceinline__ void phase_prep_even(const Params& P) {
  bf16_t* u = (bf16_t*)(P.ws + WS_U);
  const float* c128 = (const float*)(P.ws + WS_COS128); const float* s128 = (const float*)(P.ws + WS_SIN128); const float* c64 = (const float*)(P.ws + WS_COS64); const float* s64 = (const float*)(P.ws + WS_SIN64);
  const int gt = blockIdx.x * NTHREADS + otid(), NT_ = gridDim.x * NTHREADS;
  for (int w = gt; w < NB * SEQ * 208; w += NT_) {
    const int lr = w / 208, cp = w % 208, b = lr >> 12, s = lr & 4095; const size_t m = (size_t)b * TPB + CTXL + s;
    int col1, dist; const float *cp_, *sp_;
    if (cp < 128) { const int hu = cp >> 2, j = cp & 3; col1 = hu * 64 + j * 8; dist = 32; cp_ = c64 + s * 32 + j * 8; sp_ = s64 + s * 32 + j * 8; }
    else { const int c2 = cp - 128, hd = c2 >> 3, j = c2 & 7; col1 = 3072 + hd * 128 + j * 8; dist = 64; cp_ = c128 + s * 64 + j * 8; sp_ = s128 + s * 64 + j * 8; }
    bf16_t* p1 = u + m * EVEN_N + col1; bf16_t* p2 = p1 + dist;
    float x1[8], x2[8]; unpack8(*(const u32x4*)p1, x1); unpack8(*(const u32x4*)p2, x2);
    rope8(x1, x2, cp_, sp_);
    *(u32x4*)p1 = pack8(x1); *(u32x4*)p2 = pack8(x2);
  }
}

__device__ __forceinline__ void phase_prep_odd1(const Params& P, int i) {
  bf16_t* u = (bf16_t*)(P.ws + WS_U);
  const float* c128 = (const float*)(P.ws + WS_COS128); const float* s128 = (const float*)(P.ws + WS_SIN128);
  const int gt = blockIdx.x * NTHREADS + otid(), NT_ = gridDim.x * NTHREADS;
  for (int w = gt; w < MTOK * 2 * 8; w += NT_) {
    const int unit = w >> 3, j = w & 7, m = unit >> 1, hd = 8 + (unit & 1), t = m % TPB;
    const float* g = P.in[I_CKG] + i * 128;
    bf16_t* p1 = u + (size_t)m * ODD_N + hd * 128 + j * 8; bf16_t* p2 = p1 + 64;
    float x1[8], x2[8]; unpack8(*(const u32x4*)p1, x1); unpack8(*(const u32x4*)p2, x2);
    float ss = 0.f;
#pragma unroll
    for (int k = 0; k < 8; ++k) ss += x1[k] * x1[k] + x2[k] * x2[k];
    ss += __shfl_xor(ss, 1); ss += __shfl_xor(ss, 2); ss += __shfl_xor(ss, 4);
    const float rstd = rsqrtf(ss * (1.f / 128.f) + EPS);
    float g1[8], g2[8]; ld8f(g + j * 8, g1); ld8f(g + 64 + j * 8, g2);
#pragma unroll
    for (int k = 0; k < 8; ++k) { x1[k] = x1[k] * rstd * g1[k]; x2[k] = x2[k] * rstd * g2[k]; }
    if (t >= CTXL) { const int s = t - CTXL; rope8(x1, x2, c128 + s * 64 + j * 8, s128 + s * 64 + j * 8); }
    *(u32x4*)p1 = pack8(x1); *(u32x4*)p2 = pack8(x2);
  }
  const int tid2 = otid(), lane = tid2 & 63, wave = tid2 >> 6;
  const float* gq = P.in[I_DQAG] + i * 512; const float* gkv = P.in[I_DKVAG] + i * 256;
  {
    const int l2 = lane & 31, stride = gridDim.x * 8;
    float gq8[8], gkv8[8]; ld8f(gq + lane * 8, gq8); ld8f(gkv + l2 * 8, gkv8);
    int m = blockIdx.x * 8 + wave;
    u32x4 nq = {0u, 0u, 0u, 0u}, nk = {0u, 0u, 0u, 0u};
    if (m < MTOK) { nq = *(const u32x4*)(u + (size_t)m * ODD_N + 1536 + lane * 8); nk = *(const u32x4*)(u + (size_t)m * ODD_N + 2048 + l2 * 8); }
    while (m < MTOK) {
      bf16_t* pq = u + (size_t)m * ODD_N + 1536 + lane * 8; bf16_t* pk = u + (size_t)m * ODD_N + 2048 + l2 * 8;
      float x[8], y[8]; unpack8(nq, x); unpack8(nk, y);
      const int mn = m + stride;
      if (mn < MTOK) { nq = *(const u32x4*)(u + (size_t)mn * ODD_N + 1536 + lane * 8); nk = *(const u32x4*)(u + (size_t)mn * ODD_N + 2048 + l2 * 8); }
      float ss = 0.f, st = 0.f;
#pragma unroll
      for (int k = 0; k < 8; ++k) { ss += x[k] * x[k]; st += y[k] * y[k]; }
      ss = wave_sum(ss);
#pragma unroll
      for (int o = 1; o < 32; o <<= 1) st += __shfl_xor(st, o);
      const float rq = rsqrtf(ss * (1.f / 512.f) + EPS), rk = rsqrtf(st * (1.f / 256.f) + EPS);
#pragma unroll
      for (int k = 0; k < 8; ++k) { x[k] = x[k] * rq * gq8[k]; y[k] = y[k] * rk * gkv8[k]; }
      *(u32x4*)pq = pack8(x);
      if (lane < 32) *(u32x4*)pk = pack8(y);
      m = mn;
    }
  }
}

__device__ __forceinline__ void phase_prep_odd2(const Params& P) {
  const bf16_t* u = (const bf16_t*)(P.ws + WS_U); bf16_t* qd = (bf16_t*)(P.ws + WS_QD); bf16_t* kvd = (bf16_t*)(P.ws + WS_KVD);
  const float* c64 = (const float*)(P.ws + WS_COS64); const float* s64 = (const float*)(P.ws + WS_SIN64);
  const int gt = blockIdx.x * NTHREADS + otid(), NT_ = gridDim.x * NTHREADS;
  for (int w = gt; w < MTOK * 4; w += NT_) {
    const int m = w >> 2, cp = 32 + (w & 3), t = m % TPB; const bool lat = t >= CTXL; const int s = t - CTXL;
    if (cp < 32) {
      if (!lat) continue;
      const int hd = cp >> 2, j = cp & 3; bf16_t* p1 = qd + (size_t)m * QD_N + hd * 192 + 128 + j * 8; bf16_t* p2 = p1 + 32;
      float x1[8], x2[8]; unpack8(*(const u32x4*)p1, x1); unpack8(*(const u32x4*)p2, x2);
      rope8(x1, x2, c64 + s * 32 + j * 8, s64 + s * 32 + j * 8);
      *(u32x4*)p1 = pack8(x1); *(u32x4*)p2 = pack8(x2);
    } else {
      const int j = cp - 32; const bf16_t* p1 = u + (size_t)m * ODD_N + 2304 + j * 8; const bf16_t* p2 = p1 + 32;
      float x1[8], x2[8]; unpack8(*(const u32x4*)p1, x1); unpack8(*(const u32x4*)p2, x2);
      if (lat) rope8(x1, x2, c64 + s * 32 + j * 8, s64 + s * 32 + j * 8);
      const u32x4 o1 = pack8(x1), o2 = pack8(x2);
#pragma unroll
      for (int hd = 0; hd < 8; ++hd) { bf16_t* d = kvd + (size_t)m * KVD_N + hd * 320 + 128 + j * 8; *(u32x4*)d = o1; *(u32x4*)(d + 32) = o2; }
    }
  }
}

__device__ __forceinline__ void phase_post(const Params& P, int l) {
  const int tid = otid(), lane = tid & 63, wave = tid >> 6; const bool even = (l & 1) == 0; const int i = l >> 1;
  const float* mix = (const float*)(P.ws + WS_MIX); const bf16_t* u = (const bf16_t*)(P.ws + WS_U); bf16_t* y = (bf16_t*)(P.ws + WS_H);
  const int ldu = even ? EVEN_N : ODD_N, goff = even ? 4608 : 2560;
  const float lam = even ? ((const float*)(P.ws + WS_LAM))[i] : 0.f; const float one_m = even ? (i == 0 ? 0.8f : (1.f - 0.47071301834358416f)) : 0.f;
  const float* subg = P.in[I_SUBG] + i * 128;
  const bool skip_ctx = (l == 3);
  for (int m = blockIdx.x * 8 + wave; m < MTOK; m += gridDim.x * 8) {
    if (skip_ctx && (m % TPB) < CTXL) continue;
    const float* mr = mix + (size_t)m * MIXW + lane * 4; const bf16_t* ur = u + (size_t)m * ldu + goff + lane * 4; bf16_t* yr = y + (size_t)m * DM + lane * 4;
#pragma unroll
    for (int j = 0; j < 8; ++j) {
      f32x4 v = *(const f32x4*)(mr + 256 * j);
      if (even && j < 4) {
        const f32x4 v2 = *(const f32x4*)(mr + 2048 + 256 * j); v = v - lam * v2;
        float ss = (v.x * v.x + v.y * v.y) + (v.z * v.z + v.w * v.w);
#pragma unroll
        for (int o = 1; o < 32; o <<= 1) ss += __shfl_xor(ss, o);
        const float rstd = rsqrtf(ss * (1.f / 128.f) + EPS);
        const f32x4 gg = *(const f32x4*)(subg + (lane & 31) * 4);
        v = v * rstd * gg * one_m;
      }
      const u32x2 gw = *(const u32x2*)(ur + 256 * j);
      const float g0 = bf_lo(gw.x), g1 = bf_hi(gw.x), g2 = bf_lo(gw.y), g3 = bf_hi(gw.y);
      u32x2 o; o.x = cvt_pk_bf16(v.x * silu_f(g0), v.y * silu_f(g1)); o.y = cvt_pk_bf16(v.z * silu_f(g2), v.w * silu_f(g3));
      *(u32x2*)(yr + 256 * j) = o;
    }
  }
}

__device__ __forceinline__ void phase_final(const Params& P) {
  const int tid = otid(), lane = tid & 63, wave = tid >> 6;
  const float* xw = (const float*)(P.ws + WS_XW); const float* g = P.in[I_FINALG];
  const int stride = gridDim.x * 8;
  int r = blockIdx.x * 8 + wave;
  f32x4 xn[8], gg[8];
#pragma unroll
  for (int j = 0; j < 8; ++j) gg[j] = *(const f32x4*)(g + lane * 4 + 256 * j);
  if (r < NB * SEQ) { const float* xr = xw + ((size_t)(r >> 12) * TPB + CTXL + (r & 4095)) * DM + lane * 4;
#pragma unroll
    for (int j = 0; j < 8; ++j) xn[j] = *(const f32x4*)(xr + 256 * j); }
  while (r < NB * SEQ) {
    float* orow = P.out + (size_t)r * DM + lane * 4;
    f32x4 x[8]; float ss = 0.f;
#pragma unroll
    for (int j = 0; j < 8; ++j) x[j] = xn[j];
    const int rn = r + stride;
    if (rn < NB * SEQ) { const float* xr = xw + ((size_t)(rn >> 12) * TPB + CTXL + (rn & 4095)) * DM + lane * 4;
#pragma unroll
      for (int j = 0; j < 8; ++j) xn[j] = *(const f32x4*)(xr + 256 * j); }
#pragma unroll
    for (int j = 0; j < 8; ++j) ss += (x[j].x * x[j].x + x[j].y * x[j].y) + (x[j].z * x[j].z + x[j].w * x[j].w);
    const float rstd = rsqrtf(wave_sum(ss) * (1.f / DM) + EPS);
#pragma unroll
    for (int j = 0; j < 8; ++j) *(f32x4*)(orow + 256 * j) = (x[j] * rstd) * gg[j];
    r = rn;
  }
}

#ifndef ASD
#define ASD 1
#endif
#ifdef PROBE_MASK
#define TICK(cls) do { const unsigned long long t_now = __builtin_amdgcn_s_memrealtime(); if ((PROBE_MASK >> (cls)) & 1) t_acc += t_now - t_prev; t_prev = t_now; } while (0)
#else
#define TICK(cls) do { } while (0)
#endif
__device__ __forceinline__ int xcd_perm(int id) { const int r = id >> 8, c = id & 255; const int p = (((c & 7) * 2 + ((c >> 3) >> 4)) << 4) + ((c >> 3) & 15); return (r << 8) + p; }

__device__ __forceinline__ void phase_attn(const Params& P, int l, char* lds, unsigned long long& t_acc, unsigned long long& t_prev) {
  const bool even = (l & 1) == 0; const int i = l >> 1; const bool with_ctx = l < 3;
  const bf16_t* u = (const bf16_t*)(P.ws + WS_U); const bf16_t* qd = (const bf16_t*)(P.ws + WS_QD); const bf16_t* kvd = (const bf16_t*)(P.ws + WS_KVD);
  float* mix = (float*)(P.ws + WS_MIX);
  bf16_t* y = (bf16_t*)(P.ws + WS_H);
  const int ldu = even ? EVEN_N : ODD_N, goff = even ? 4608 : 2560;
  const float lam = even ? ((const float*)(P.ws + WS_LAM))[i] : 0.f; const float one_m = i == 0 ? 0.8f : (1.f - 0.47071301834358416f);
  const float* subg = P.in[I_SUBG] + i * 128;
  const int nlat = 512, nall = with_ctx ? 544 : nlat;
  for (int it = blockIdx.x; it < nall; it += gridDim.x) {
    int type, b, hd, qb;
    if (it < nlat) { const int id = xcd_perm(it); const int g = (id & 255) >> 4; type = (even ? 0 : 2) + (id >> 8); b = g >> 3; hd = g & 7; qb = (id & 15) + 1; }
    else { const int id = it - nlat; qb = 0; type = (even ? 0 : 2) + (id >> 4); b = (id & 15) >> 3; hd = id & 7; }
    const size_t row0 = (size_t)b * TPB + (size_t)qb * 256, rowb = (size_t)b * TPB;
    int NT = qb == 0 ? 4 : 68, lo = 0; const int q0 = qb > 0 ? (qb - 1) * 256 : 0; float sink = -1e30f;
    const float* c64 = (const float*)(P.ws + WS_COS64); const float* s64 = (const float*)(P.ws + WS_SIN64); const float* c128 = (const float*)(P.ws + WS_COS128); const float* s128 = (const float*)(P.ws + WS_SIN128);
    const int ycol = ((type & 1) ? 1024 : 0) + hd * 128;
    bf16_t* yb = y + row0 * DM + ycol; const bf16_t* ugb = u + row0 * ldu + goff + ycol;
    TICK(14);
    if (type == 0) {
      float* Op = mix + (size_t)blockIdx.x * 32768;
      for (int half = 0; half < 2; ++half) {
        __syncthreads();
        att::attn_body<64, 2, false, EVEN_N, EVEN_N, EVEN_N>(u + row0 * EVEN_N + hd * 128 + half * 64, u + rowb * EVEN_N + 1024 + hd * 128 + half * 64, u + rowb * EVEN_N + 2048 + hd * 128,
                                     Op, NT, 0, q0, sink, lds, yb, ugb, half + 1, lam, one_m, subg, qb > 0 ? c64 : nullptr, s64, nullptr);
      }
    } else if (type == 1) {
      if (qb > 0) { lo = q0 >= 128 ? q0 - 128 : 0; const int hk = (q0 + 384) < SEQ ? (q0 + 384) : SEQ; NT = 4 + (hk - lo) / 64; }
      sink = P.in[I_SINK][i * 8 + hd] * 1.4426950408889634f;
      __syncthreads();
      att::attn_body<128, 1, true, EVEN_N, EVEN_N, EVEN_N>(u + row0 * EVEN_N + 3072 + hd * 128, u + rowb * EVEN_N + 4096 + (hd >> 2) * 128, u + rowb * EVEN_N + 4352 + (hd >> 2) * 128,
                                   nullptr, NT, lo, q0, sink, lds, yb, ugb, 0, 0.f, 0.f, subg, qb > 0 ? c128 : nullptr, s128, nullptr);
    } else if (type == 2) {
      __syncthreads();
      att::attn_body<128, 2, false, ODD_N, ODD_N, ODD_N>(u + row0 * ODD_N + hd * 128, u + rowb * ODD_N + 1024 + (hd >> 2) * 128, u + rowb * ODD_N + 1280 + (hd >> 2) * 128,
                                    nullptr, NT, 0, q0, sink, lds, yb, ugb, 0, 0.f, 0.f, subg, qb > 0 ? c128 : nullptr, s128, P.in[I_CQG] + i * 128);
    } else {
      __syncthreads();
      att::attn_body<192, 1, false, QD_N, KVD_N, ODD_N>(qd + row0 * QD_N + hd * 192, kvd + rowb * KVD_N + hd * 320, kvd + rowb * KVD_N + hd * 320 + 192,
                                    nullptr, NT, 0, q0, sink, lds, yb, ugb, 0, 0.f, 0.f, subg, qb > 0 ? c64 : nullptr, s64, nullptr);
    }
    TICK(10 + type);
  }
}

__global__ void __launch_bounds__(NTHREADS) mega_fwd(Params P) {
  extern __shared__ __attribute__((aligned(16))) unsigned char lds_raw[];
  cg::grid_group grid = cg::this_grid();
  char* lds = (char*)lds_raw; LAS unsigned char* ldsl = (LAS unsigned char*)lds_raw;
  unsigned char* ws = P.ws;
  const int G = gridDim.x, bx = blockIdx.x;

#ifdef PROBE_MASK
  unsigned long long t_acc = 0, t_prev = __builtin_amdgcn_s_memrealtime();
#else
  unsigned long long t_acc = 0, t_prev = 0;
#endif
  volatile LAS unsigned* bst = (volatile LAS unsigned*)(ldsl + LDS_MAIN);
  if (threadIdx.x < 2) bst[threadIdx.x] = 0u;
  __syncthreads();
  XcdBarrier xb = xcd_barrier_post((unsigned*)(ws + WS_BAR), bst);
#define GSYNC() xcd_barrier(xb)
  phase_p0(P, lds);
  if (P.ws == nullptr) grid.sync();
  GSYNC(); TICK(0);
  for (int l = 0; l < 4; ++l) {
    const bool even = (l & 1) == 0; const int i = l >> 1;
    phase_norm(P, l);
    GSYNC(); TICK(1);
    {
      const int N = even ? EVEN_N : ODD_N;
      const bf16_t* Wt = even ? (const bf16_t*)(ws + WS_WE) + (size_t)i * EVEN_N * DM : (const bf16_t*)(ws + WS_WO_IN) + (size_t)i * ODD_N * DM;
      pg8::Gemm g{(const bf16_t*)(ws + WS_H), Wt, MTOK, N, DM, DM}; pg8::StaticOrder S; S.init(MTOK, N, DM, G, bx);
      pg8::EpiBf16 E{(bf16_t*)(ws + WS_U), N, 0, even ? 1 : 0, (const float*)(ws + WS_COS64), (const float*)(ws + WS_SIN64), (const float*)(ws + WS_COS128), (const float*)(ws + WS_SIN128)};
      pg8::gemm_phase<pg8::EpiBf16, pg8::StaticOrder>(ldsl, g, S, E);
      if (l < 3) {
        const int nwg = (MTOK / 256) * (N / 256), rounds = (nwg + G - 1) / G, first_idle = nwg - (rounds - 1) * G;
        if (first_idle < G && bx >= first_idle) { job_mod(P, lds, l + 1, bx - first_idle, G - first_idle); job_convert(P, lds, l + 1, bx - first_idle, G - first_idle); }
        else if (first_idle >= G) { job_mod(P, lds, l + 1, bx, G); job_convert(P, lds, l + 1, bx, G); }
      }
    }
    GSYNC(); TICK(2);
    if (!even) {
      phase_prep_odd1(P, i);
      phase_prep_odd2(P);
      GSYNC(); TICK(3);
      for (int k = 0; k < 2; ++k) {
        const int N = k == 0 ? QD_N : KVD_N, K = k == 0 ? 512 : 256;
        const bf16_t* A = (const bf16_t*)(ws + WS_U) + (k == 0 ? 1536 : 2048);
        const bf16_t* Wt = k == 0 ? (const bf16_t*)(ws + WS_WQB) + (size_t)i * QD_N * 512 : (const bf16_t*)(ws + WS_WKVB) + (size_t)i * KVD_N * 256;
        pg8::Gemm g{A, Wt, MTOK, N, K, ODD_N}; pg8::StaticOrder S; S.init(MTOK, N, K, G, bx);
        pg8::EpiBf16 E{(bf16_t*)(ws + (k == 0 ? WS_QD : WS_KVD)), N, k, 0, nullptr, nullptr, nullptr, nullptr};
        pg8::gemm_phase<pg8::EpiBf16, pg8::StaticOrder>(ldsl, g, S, E);
      }
      GSYNC(); TICK(7);
    }
    phase_attn(P, l, lds, t_acc, t_prev);
    GSYNC(); TICK(4);
    {
      pg8::Gemm g{(const bf16_t*)(ws + WS_H), (const bf16_t*)(ws + WS_WOUT) + (size_t)l * DM * DM, MTOK, DM, DM, DM}; pg8::OutOrder S; S.init(G, bx, l < 3);
      pg8::EpiResid E{(float*)(ws + WS_XW), (const float*)(ws + WS_MOD) + (size_t)l * 3 * 6144 + 4096, (float*)(ws + WS_PART), l == 0 ? P.in[I_X] : nullptr};
      pg8::gemm_phase<pg8::EpiResid, pg8::OutOrder>(ldsl, g, S, E);
    }
    GSYNC(); TICK(6);
  }
  phase_final(P);
#ifdef PROBE_MASK
  GSYNC(); TICK(8);
  if (bx == 0) { int n = (int)(t_acc / 100ull); if (n > 8000) n = 8000; for (int k = otid(); k < n; k += NTHREADS) P.out[(size_t)k * 2048 + 7] += 0.05f; }
#endif
}

extern "C" void kernel_launch(void* const* d_in, const int* in_sizes, int n_in, void* d_out, int out_size, void* d_ws, size_t ws_size, hipStream_t stream) {
  static int grid_blocks = 0;
  if (grid_blocks == 0) {
    if (n_in != 23 || in_sizes[0] != NB * SEQ * DM || out_size != NB * SEQ * DM || ws_size < WS_END) {
      fprintf(stderr, "kernel_launch: shape mismatch: n_in %d in0 %d out %d ws %zu (need %zu)\n", n_in, n_in > 0 ? in_sizes[0] : -1, out_size, ws_size, (size_t)WS_END); grid_blocks = -1; return; }
    int dev = 0, cus = 0, per_cu = 0;
    hipGetDevice(&dev); hipDeviceGetAttribute(&cus, hipDeviceAttributeMultiprocessorCount, dev);
    if (hipFuncSetAttribute((const void*)mega_fwd, hipFuncAttributeMaxDynamicSharedMemorySize, LDS_BYTES) != hipSuccess) { fprintf(stderr, "kernel_launch: hipFuncSetAttribute failed\n"); grid_blocks = -1; return; }
    if (hipOccupancyMaxActiveBlocksPerMultiprocessor(&per_cu, (const void*)mega_fwd, NTHREADS, LDS_BYTES) != hipSuccess || per_cu < 1) { fprintf(stderr, "kernel_launch: occupancy query gave %d\n", per_cu); per_cu = 1; (void)hipGetLastError(); }
    grid_blocks = cus * 1;
    fprintf(stderr, "kernel_launch: cus %d per_cu %d grid %d\n", cus, per_cu, grid_blocks);
  }
  if (grid_blocks < 0) return;
  if (hipMemsetAsync((unsigned char*)d_ws + WS_BAR, 0, (size_t)XCD_BAR_WORDS * 4, stream) != hipSuccess) { fprintf(stderr, "kernel_launch: memset failed\n"); return; }
  Params p{};
  for (int k = 0; k < 23; ++k) p.in[k] = (const float*)d_in[k];
  p.out = (float*)d_out; p.ws = (unsigned char*)d_ws;
  void* args[] = {&p};
  hipError_t e = hipLaunchCooperativeKernel((const void*)mega_fwd, dim3(grid_blocks), dim3(NTHREADS), args, LDS_BYTES, stream);
  if (e != hipSuccess) fprintf(stderr, "kernel_launch: cooperative launch failed: %s (grid %d)\n", hipGetErrorString(e), grid_blocks);
}
```
